# Optimizing an MI355X kernel written in HIP

```python
import math
import jax, jax.numpy as jnp
from jax import lax
import numpy as np

D_MODEL = 1024
BATCH = 16
SEQ = 256
DEPTH = 2
DEC_BATCH = 2
DEC_SEQ = 1024
PAST_LEN = 256

GRID_W = 64
HEAD_DIM = 64
Q_BLOCK = 128
WINDOW = 128
ROPE_THETA = 10000.0
EPS = 1e-6
NEG_INF = -1e30
A_HEADS = D_MODEL // (2 * HEAD_DIM)
A_KV_HEADS = 2
B_HEADS = D_MODEL // (2 * HEAD_DIM)
B_KV_HEADS = 2
C_HEADS = D_MODEL // (2 * HEAD_DIM)
C_VDIM = 2 * HEAD_DIM
A_W = A_HEADS * HEAD_DIM
B_W = B_HEADS * HEAD_DIM
A_KVW = A_KV_HEADS * HEAD_DIM
B_KVW = B_KV_HEADS * HEAD_DIM
C_QW = C_HEADS * 2 * HEAD_DIM
C_W = C_HEADS * C_VDIM
EVEN_IN = 2 * A_W + 2 * A_KVW + 2 * B_W + 2 * B_KVW
ODD_IN = 2 * C_QW + 2 * C_W
N_EVEN = (DEPTH + 1) // 2
N_ODD = DEPTH // 2
ALPHA = (2 * DEPTH) ** 0.25
BETA = (8 * DEPTH) ** -0.25

kernel_name = 'hybrid_diffusion_prefix_trunk_step'


def _split(p, sizes):
    idx = [int(v) for v in np.cumsum(sizes)[:-1]]
    return jnp.split(p, idx, axis=-1)


def rms_norm(x, w):
    xf = x.astype(jnp.float32)
    y = xf * lax.rsqrt(jnp.mean(xf * xf, -1, keepdims=True) + EPS)
    return (y * w.astype(jnp.float32)).astype(x.dtype)


def layer_norm(x, g, b):
    xf = x.astype(jnp.float32)
    mu = jnp.mean(xf, -1, keepdims=True)
    xc = xf - mu
    var = jnp.mean(xc * xc, -1, keepdims=True)
    y = xc * lax.rsqrt(var + EPS) * g.astype(jnp.float32) + b.astype(jnp.float32)
    return y.astype(x.dtype)


def adaln(cvec, w_mod, b_mod):
    m = jax.nn.silu(cvec) @ w_mod + b_mod
    if m.ndim == 2:
        m = m[:, None, :]
    return jnp.split(m, 3, axis=-1)


def axial_angles(n_tokens):
    t = jnp.arange(n_tokens)
    row = (t // GRID_W).astype(jnp.float32)
    col = (t % GRID_W).astype(jnp.float32)
    n_freq = HEAD_DIM // 4
    freqs = ROPE_THETA ** (-jnp.arange(n_freq, dtype=jnp.float32) / n_freq)
    return row[:, None] * freqs, col[:, None] * freqs


def _rot(x, ang):
    m = ang.shape[-1]
    c = jnp.cos(ang)[:, None, :]
    s = jnp.sin(ang)[:, None, :]
    x1, x2 = x[..., :m], x[..., m:]
    return jnp.concatenate([x1 * c - x2 * s, x1 * s + x2 * c], -1)


def rope_2d(x, ang_row, ang_col):
    half = HEAD_DIM // 2
    xf = x.astype(jnp.float32)
    out = jnp.concatenate([_rot(xf[..., :half], ang_row), _rot(xf[..., half:], ang_col)], -1)
    return out.astype(x.dtype)


def dense_attention(q, k, v, sink=None):
    b, sq, kvh, g, dq = q.shape
    nb = sq // Q_BLOCK
    scale = dq ** -0.5
    kf = k.astype(jnp.float32)
    vf = v.astype(jnp.float32)
    qb = q.reshape(b, nb, Q_BLOCK, kvh, g, dq).transpose(1, 0, 2, 3, 4, 5)

    def block(qblk):
        s = jnp.einsum('bqkgd,bskd->bkgqs', qblk.astype(jnp.float32), kf) * scale
        if sink is not None:
            sk = jnp.broadcast_to(sink.astype(jnp.float32)[None, :, :, None, None], s.shape[:-1] + (1,))
            p = jax.nn.softmax(jnp.concatenate([s, sk], -1), axis=-1)[..., :-1]
        else:
            p = jax.nn.softmax(s, axis=-1)
        return jnp.einsum('bkgqs,bskd->bqkgd', p, vf)

    o = lax.map(block, qb)
    return o.transpose(1, 0, 2, 3, 4, 5).reshape(b, sq, kvh, g, -1).astype(q.dtype)


def window_attention(q, k, v, k_ctx, v_ctx, sink):
    b, s, kvh, g, d = q.shape
    nb = s // Q_BLOCK
    scale = d ** -0.5
    pad = ((0, 0), (Q_BLOCK, Q_BLOCK), (0, 0), (0, 0))
    kp = jnp.pad(k.astype(jnp.float32), pad).reshape(b, nb + 2, Q_BLOCK, kvh, d)
    vp = jnp.pad(v.astype(jnp.float32), pad).reshape(b, nb + 2, Q_BLOCK, kvh, d)
    kband = jnp.concatenate([kp[:, :-2], kp[:, 1:-1], kp[:, 2:]], axis=2)
    vband = jnp.concatenate([vp[:, :-2], vp[:, 1:-1], vp[:, 2:]], axis=2)
    qb = q.astype(jnp.float32).reshape(b, nb, Q_BLOCK, kvh, g, d)
    s_loc = jnp.einsum('bnqkgd,bnskd->bnkgqs', qb, kband) * scale
    blk = jnp.arange(nb)[:, None, None]
    i = blk * Q_BLOCK + jnp.arange(Q_BLOCK)[None, :, None]
    j = blk * Q_BLOCK - Q_BLOCK + jnp.arange(3 * Q_BLOCK)[None, None, :]
    valid = (jnp.abs(j - i) <= WINDOW) & (j >= 0) & (j < s)
    s_loc = jnp.where(valid[None, :, None, None], s_loc, NEG_INF)
    s_ctx = jnp.einsum('bnqkgd,bskd->bnkgqs', qb, k_ctx.astype(jnp.float32)) * scale
    sk = jnp.broadcast_to(sink.astype(jnp.float32)[None, None, :, :, None, None], s_loc.shape[:-1] + (1,))
    p = jax.nn.softmax(jnp.concatenate([s_loc, s_ctx, sk], -1), axis=-1)
    n_loc = 3 * Q_BLOCK
    o = (jnp.einsum('bnkgqs,bnskd->bnqkgd', p[..., :n_loc], vband)
         + jnp.einsum('bnkgqs,bskd->bnqkgd', p[..., n_loc:-1], v_ctx.astype(jnp.float32)))
    return o.reshape(b, s, kvh, g, d).astype(q.dtype)


def even_mixer(h, w_in, w_out, q_norm, k_norm, sink, angles, kv_ctx):
    b, s, _ = h.shape
    qa, ka, va, ga, qb, kb, vb, gb = _split(h @ w_in, [A_W, A_KVW, A_KVW, A_W, B_W, B_KVW, B_KVW, B_W])
    qa = rms_norm(qa.reshape(b, s, A_HEADS, HEAD_DIM), q_norm)
    ka = rms_norm(ka.reshape(b, s, A_KV_HEADS, HEAD_DIM), k_norm)
    va = va.reshape(b, s, A_KV_HEADS, HEAD_DIM)
    qb = qb.reshape(b, s, B_HEADS, HEAD_DIM)
    kb = kb.reshape(b, s, B_KV_HEADS, HEAD_DIM)
    vb = vb.reshape(b, s, B_KV_HEADS, HEAD_DIM)
    new_kv = (ka, va, kb, vb)
    sink_g = sink.reshape(B_KV_HEADS, B_HEADS // B_KV_HEADS)
    if angles is None:
        oa = dense_attention(qa.reshape(b, s, A_KV_HEADS, -1, HEAD_DIM), ka, va)
        ob = dense_attention(qb.reshape(b, s, B_KV_HEADS, -1, HEAD_DIM), kb, vb, sink_g)
    else:
        ka_c, va_c, kb_c, vb_c = kv_ctx
        qa = rope_2d(qa, *angles)
        ka_r = rope_2d(ka, *angles)
        qb = rope_2d(qb, *angles)
        kb_r = rope_2d(kb, *angles)
        oa = dense_attention(qa.reshape(b, s, A_KV_HEADS, -1, HEAD_DIM),
                             jnp.concatenate([ka_r, ka_c.astype(ka_r.dtype)], 1),
                             jnp.concatenate([va, va_c.astype(va.dtype)], 1))
        ob = window_attention(qb.reshape(b, s, B_KV_HEADS, -1, HEAD_DIM), kb_r, vb, kb_c, vb_c, sink_g)
    oa = oa.reshape(b, s, A_W) * jax.nn.silu(ga)
    ob = ob.reshape(b, s, B_W) * jax.nn.silu(gb)
    return jnp.concatenate([oa, ob], -1) @ w_out, new_kv


def odd_mixer(h, w_in, w_out, lq1, lk1, lq2, lk2, subln, lam_init, angles, kv_ctx):
    b, s, _ = h.shape
    q, k, v, g = _split(h @ w_in, [C_QW, C_QW, C_W, C_W])
    q = q.reshape(b, s, 2 * C_HEADS, HEAD_DIM)
    k = k.reshape(b, s, 2 * C_HEADS, HEAD_DIM)
    v = v.reshape(b, s, C_HEADS, C_VDIM)
    if angles is not None:
        q = rope_2d(q, *angles)
        k = rope_2d(k, *angles)
    k = k.reshape(b, s, C_HEADS, 2 * HEAD_DIM)
    new_kv = (k, v)
    if kv_ctx is None:
        k_all, v_all = k, v
    else:
        k_all = jnp.concatenate([k, kv_ctx[0].astype(k.dtype)], 1)
        v_all = jnp.concatenate([v, kv_ctx[1].astype(v.dtype)], 1)
    q = q.reshape(b, s, C_HEADS, 1, 2 * HEAD_DIM)
    o1 = dense_attention(q[..., :HEAD_DIM], k_all[..., :HEAD_DIM], v_all)
    o2 = dense_attention(q[..., HEAD_DIM:], k_all[..., HEAD_DIM:], v_all)
    lam = (jnp.exp(jnp.sum(lq1.astype(jnp.float32) * lk1.astype(jnp.float32)))
           - jnp.exp(jnp.sum(lq2.astype(jnp.float32) * lk2.astype(jnp.float32))) + lam_init)
    o = (o1.astype(jnp.float32) - lam * o2.astype(jnp.float32))[:, :, :, 0, :]
    o = rms_norm(o, subln) * (1.0 - lam_init)
    o = o.reshape(b, s, C_W).astype(h.dtype) * jax.nn.silu(g)
    return o @ w_out, new_kv


def setup_inputs(seed: int = 0) -> dict:
    key = jax.random.key(seed)
    ks = jax.random.split(key, 32)
    f32 = jnp.float32
    nrm = lambda k, shape, sc=1.0: (jax.random.normal(k, shape, f32) * sc).astype(f32)
    d = D_MODEL
    return {
        'x_prompt': nrm(ks[0], (BATCH, SEQ, d)),
        'x_sample': nrm(ks[1], (DEC_BATCH, DEC_SEQ, d)),
        'cache_a_k': nrm(ks[2], (DEC_BATCH, N_EVEN, PAST_LEN, A_KV_HEADS, HEAD_DIM)),
        'cache_a_v': nrm(ks[3], (DEC_BATCH, N_EVEN, PAST_LEN, A_KV_HEADS, HEAD_DIM)),
        'cache_b_k': nrm(ks[4], (DEC_BATCH, N_EVEN, PAST_LEN, B_KV_HEADS, HEAD_DIM)),
        'cache_b_v': nrm(ks[5], (DEC_BATCH, N_EVEN, PAST_LEN, B_KV_HEADS, HEAD_DIM)),
        'cache_c_k': nrm(ks[6], (DEC_BATCH, N_ODD, PAST_LEN, C_HEADS, 2 * HEAD_DIM)),
        'cache_c_v': nrm(ks[7], (DEC_BATCH, N_ODD, PAST_LEN, C_HEADS, C_VDIM)),
        'c': nrm(ks[8], (DEC_BATCH, d)),
        'c_ctx': nrm(ks[9], (d,)),
        'w_mod': nrm(ks[10], (DEPTH, d, 3 * d), 0.5 * d ** -0.5),
        'b_mod': nrm(ks[11], (DEPTH, 3 * d), 0.01),
        'ln_g': 1.0 + nrm(ks[12], (DEPTH, d), 0.05),
        'ln_b': nrm(ks[13], (DEPTH, d), 0.01),
        'w_in_even': nrm(ks[14], (N_EVEN, d, EVEN_IN), d ** -0.5),
        'w_out_even': nrm(ks[15], (N_EVEN, A_W + B_W, d), BETA * (A_W + B_W) ** -0.5),
        'q_norm_a': 1.0 + nrm(ks[16], (N_EVEN, HEAD_DIM), 0.05),
        'k_norm_a': 1.0 + nrm(ks[17], (N_EVEN, HEAD_DIM), 0.05),
        'sink_b': nrm(ks[18], (N_EVEN, B_HEADS)),
        'w_in_odd': nrm(ks[19], (N_ODD, d, ODD_IN), d ** -0.5),
        'w_out_odd': nrm(ks[20], (N_ODD, C_W, d), BETA * C_W ** -0.5),
        'lambda_q1': nrm(ks[21], (N_ODD, HEAD_DIM), 0.1),
        'lambda_k1': nrm(ks[22], (N_ODD, HEAD_DIM), 0.1),
        'lambda_q2': nrm(ks[23], (N_ODD, HEAD_DIM), 0.1),
        'lambda_k2': nrm(ks[24], (N_ODD, HEAD_DIM), 0.1),
        'subln_c': 1.0 + nrm(ks[25], (N_ODD, C_VDIM), 0.05),
    }


def reference(x_prompt, x_sample, cache_a_k, cache_a_v, cache_b_k, cache_b_v, cache_c_k, cache_c_v,
              c, c_ctx, w_mod, b_mod, ln_g, ln_b, w_in_even, w_out_even, q_norm_a, k_norm_a, sink_b,
              w_in_odd, w_out_odd, lambda_q1, lambda_k1, lambda_q2, lambda_k2, subln_c):
    x = x_prompt
    a_k, a_v, b_k, b_v, c_k, c_v = [], [], [], [], [], []
    for l in range(DEPTH):
        shift, scale, gate = adaln(c_ctx, w_mod[l], b_mod[l])
        h = x * (1 + scale) + shift
        if l % 2 == 0:
            e = l // 2
            out, (ka, va, kb, vb) = even_mixer(h, w_in_even[e], w_out_even[e], q_norm_a[e], k_norm_a[e],
                                               sink_b[e], None, None)
            a_k.append(ka); a_v.append(va); b_k.append(kb); b_v.append(vb)
        else:
            o = l // 2
            lam_init = 0.8 - 0.6 * math.exp(-0.3 * l)
            out, (kc, vc) = odd_mixer(h, w_in_odd[o], w_out_odd[o], lambda_q1[o], lambda_k1[o],
                                      lambda_q2[o], lambda_k2[o], subln_c[o], lam_init, None, None)
            c_k.append(kc); c_v.append(vc)
        x = layer_norm(ALPHA * x + gate * out, ln_g[l], ln_b[l])
    y_prompt = x
    new_a_k = jnp.stack(a_k, axis=1)
    new_a_v = jnp.stack(a_v, axis=1)
    new_b_k = jnp.stack(b_k, axis=1)
    new_b_v = jnp.stack(b_v, axis=1)
    new_c_k = jnp.stack(c_k, axis=1)
    new_c_v = jnp.stack(c_v, axis=1)

    angles = axial_angles(x_sample.shape[1])
    x = x_sample
    for l in range(DEPTH):
        shift, scale, gate = adaln(c, w_mod[l], b_mod[l])
        h = x * (1 + scale) + shift
        if l % 2 == 0:
            e = l // 2
            kv_ctx = (cache_a_k[:, e], cache_a_v[:, e], cache_b_k[:, e], cache_b_v[:, e])
            out, _ = even_mixer(h, w_in_even[e], w_out_even[e], q_norm_a[e], k_norm_a[e],
                                sink_b[e], angles, kv_ctx)
        else:
            o = l // 2
            lam_init = 0.8 - 0.6 * math.exp(-0.3 * l)
            out, _ = odd_mixer(h, w_in_odd[o], w_out_odd[o], lambda_q1[o], lambda_k1[o],
                               lambda_q2[o], lambda_k2[o], subln_c[o], lam_init, angles,
                               (cache_c_k[:, o], cache_c_v[:, o]))
        x = layer_norm(ALPHA * x + gate * out, ln_g[l], ln_b[l])
    y_sample = x
    return (y_prompt, y_sample, new_a_k, new_a_v, new_b_k, new_b_v, new_c_k, new_c_v)
```

```cpp
#include <hip/hip_runtime.h>
#include <hip/hip_cooperative_groups.h>
#include <cstdio>
namespace cg = cooperative_groups;

#ifndef GEMM_SKEW
#define GEMM_SKEW 0
#endif
#ifndef REP_EPI
#define REP_EPI 1
#endif
#ifndef REP_MASK
#define REP_MASK 0
#endif
#ifndef N_LAUNCH_MULTI
#define N_LAUNCH_MULTI 0
#endif

#define DI __device__ __forceinline__
typedef unsigned short u16;
using bf16x8 = __attribute__((ext_vector_type(8))) short;
using f32x4 = __attribute__((ext_vector_type(4))) float;
using f32x16 = __attribute__((ext_vector_type(16))) float;
typedef __bf16 bf2_t __attribute__((ext_vector_type(2)));
typedef float f2_t __attribute__((ext_vector_type(2)));

#define MFMA16(a, b, c) __builtin_amdgcn_mfma_f32_16x16x32_bf16((a), (b), (c), 0, 0, 0)
#define MFMA32(a, b, c) __builtin_amdgcn_mfma_f32_32x32x16_bf16((a), (b), (c), 0, 0, 0)

constexpr int M_CTX = 4096, M_ALL = 6144;
constexpr float ALPHA = 1.4142135623730951f;
constexpr float EPS = 1e-6f;
constexpr float LOG2E = 1.4426950408889634f;
constexpr float QSCALE = 0.125f * LOG2E;
constexpr float LAM_INIT = 0.35550906759096926f;

enum { I_XP = 0, I_XS, I_CAK, I_CAV, I_CBK, I_CBV, I_CCK, I_CCV, I_C, I_CCTX, I_WMOD, I_BMOD, I_LNG, I_LNB,
       I_WINE, I_WOUTE, I_QNA, I_KNA, I_SINK, I_WINO, I_WOUTO, I_LQ1, I_LK1, I_LQ2, I_LK2, I_SUBLN };

constexpr size_t O_YP = 0, O_YS = 4194304, O_AK = 6291456, O_AV = 6815744, O_BK = 7340032, O_BV = 7864320,
                 O_CK = 8388608, O_CV = 12582912;

constexpr size_t OFF_MOD = 0;
constexpr size_t OFF_ROPE = OFF_MOD + 73728;
constexpr size_t OFF_CNT = OFF_ROPE + 262144;
constexpr size_t OFF_WIN0 = OFF_CNT + 256;
constexpr size_t OFF_WOUT0 = OFF_WIN0 + 5242880;
constexpr size_t OFF_WIN1 = OFF_WOUT0 + 2097152;
constexpr size_t OFF_WOUT1 = OFF_WIN1 + 8388608;
constexpr size_t OFF_H = OFF_WOUT1 + 2097152;
constexpr size_t OFF_Q = OFF_H + 12582912;
constexpr size_t OFF_G = OFF_Q + 12582912;
constexpr size_t OFF_AO = OFF_G + 12582912;
constexpr size_t OFF_KCA = OFF_AO + 12582912;
constexpr size_t OFF_VCA = OFF_KCA + 1048576;
constexpr size_t OFF_KCB = OFF_VCA + 1048576;
constexpr size_t OFF_VCB = OFF_KCB + 1048576;
constexpr size_t OFF_KSA = OFF_VCB + 1048576;
constexpr size_t OFF_VSA = OFF_KSA + 655360;
constexpr size_t OFF_KSB = OFF_VSA + 655360;
constexpr size_t OFF_VSB = OFF_KSB + 655360;
constexpr size_t OFF_KCC = OFF_VSB + 655360;
constexpr size_t OFF_VCC = OFF_KCC + 8388608;
constexpr size_t OFF_KSC = OFF_VCC + 8388608;
constexpr size_t OFF_VSC = OFF_KSC + 5242880;
constexpr size_t OFF_R = OFF_VSC + 5242880;
constexpr size_t OFF_X1 = OFF_R + 25165824;
constexpr size_t OFF_BAR = OFF_X1 + 25165824;
constexpr size_t BAR_BYTES = 16384;
constexpr size_t OFF_PART = OFF_BAR + BAR_BYTES;
constexpr size_t WS_END = OFF_PART + 786432;
constexpr int BANDCNT_WORD = 3500;
constexpr int MODCNT_WORD = 3600;

constexpr int LDS_BYTES = 2 * 2 * 128 * 64 * 2 + 64;

struct Params {
  const float* in[26];
  float* out;
  unsigned char* ws;
  int ph_lo, ph_hi;
};

DI unsigned pack2(float a, float b) {
  f2_t v = {a, b};
  bf2_t r = __builtin_convertvector(v, bf2_t);
  return __builtin_bit_cast(unsigned, r);
}
DI u16 f2bf(float x) { return (u16)(pack2(x, 0.f) & 0xffffu); }
DI float bflo(unsigned u) { return __uint_as_float(u << 16); }
DI float bfhi(unsigned u) { return __uint_as_float(u & 0xffff0000u); }
DI float exp2f_fast(float x) { return __builtin_amdgcn_exp2f(x); }
DI float silu(float x) { return x / (1.0f + __expf(-x)); }
typedef unsigned u32x4_t __attribute__((ext_vector_type(4)));
DI void st16_wt_raw(void* p, u32x4_t v) {
  asm volatile("global_store_dwordx4 %0, %1, off sc1\n\ts_nop 1" :: "v"(p), "v"(v) : "memory");
}
DI void st16_wt(void* p, uint4 v) { st16_wt_raw(p, u32x4_t{v.x, v.y, v.z, v.w}); }
DI void st16_wt(void* p, float4 v) {
  st16_wt_raw(p, u32x4_t{__float_as_uint(v.x), __float_as_uint(v.y), __float_as_uint(v.z), __float_as_uint(v.w)});
}
DI void st8_wt(void* p, uint2 v) {
  __hip_atomic_store((unsigned long long*)p, ((unsigned long long)v.y << 32) | v.x, __ATOMIC_RELAXED, __HIP_MEMORY_SCOPE_AGENT);
}
DI float wave_sum(float v) {
  v += __shfl_xor(v, 32); v += __shfl_xor(v, 16); v += __shfl_xor(v, 8);
  v += __shfl_xor(v, 4); v += __shfl_xor(v, 2); v += __shfl_xor(v, 1);
  return v;
}
DI float sum16(float v) {
  v += __shfl_xor(v, 8); v += __shfl_xor(v, 4); v += __shfl_xor(v, 2); v += __shfl_xor(v, 1);
  return v;
}
DI const float* xrow(const Params& p, int row) {
  return row < M_CTX ? p.in[I_XP] + (size_t)row * 1024 : p.in[I_XS] + (size_t)(row - M_CTX) * 1024;
}
DI int modvec(int row) { return row < M_CTX ? 0 : 1 + ((row - M_CTX) >> 10); }

DI void phase_h0(const Params& p) {
  const int gtid = blockIdx.x * 256 + threadIdx.x, gsz = gridDim.x * 256;
  const float* mod = (const float*)(p.ws + OFF_MOD);
  u16* H = (u16*)(p.ws + OFF_H);
  for (int idx = gtid; idx < M_ALL * 128; idx += gsz) {
    const int row = idx >> 7, c = (idx & 127) * 8;
    const float* x = xrow(p, row) + c;
    const float* mv = mod + modvec(row) * 3072;
    const float4 x0 = *(const float4*)x, x1 = *(const float4*)(x + 4);
    const float4 sh0 = *(const float4*)(mv + c), sh1 = *(const float4*)(mv + c + 4);
    const float4 sc0 = *(const float4*)(mv + 1024 + c), sc1 = *(const float4*)(mv + 1024 + c + 4);
    uint4 o;
    o.x = pack2(x0.x * (1.f + sc0.x) + sh0.x, x0.y * (1.f + sc0.y) + sh0.y);
    o.y = pack2(x0.z * (1.f + sc0.z) + sh0.z, x0.w * (1.f + sc0.w) + sh0.w);
    o.z = pack2(x1.x * (1.f + sc1.x) + sh1.x, x1.y * (1.f + sc1.y) + sh1.y);
    o.w = pack2(x1.z * (1.f + sc1.z) + sh1.z, x1.w * (1.f + sc1.w) + sh1.w);
    st16_wt(H + (size_t)row * 1024 + c, o);
  }
}

DI void prep_item(const Params& p, unsigned char* smem, int item, int tid) {
  float* fs = (float*)smem;
  {
    if (item < 192) {
      const int l = item / 96, n0 = (item % 96) * 32;
      const int cq = tid & 7, kg = tid >> 3;
      const float* W = p.in[I_WMOD] + (size_t)l * 1024 * 3072 + n0 + cq * 4;
      const float* cc = p.in[I_CCTX];
      const float* c1 = p.in[I_C];
      float a0[4] = {0, 0, 0, 0}, a1[4] = {0, 0, 0, 0}, a2[4] = {0, 0, 0, 0};
#pragma unroll 16
      for (int i = 0; i < 32; ++i) {
        const int k = kg * 32 + i;
        const f32x4 wv_ = __builtin_nontemporal_load((const f32x4*)(W + (size_t)k * 3072)); const float4 w = {wv_[0], wv_[1], wv_[2], wv_[3]};
        const float s0 = silu(cc[k]), s1 = silu(c1[k]), s2 = silu(c1[1024 + k]);
        a0[0] += s0 * w.x; a0[1] += s0 * w.y; a0[2] += s0 * w.z; a0[3] += s0 * w.w;
        a1[0] += s1 * w.x; a1[1] += s1 * w.y; a1[2] += s1 * w.z; a1[3] += s1 * w.w;
        a2[0] += s2 * w.x; a2[1] += s2 * w.y; a2[2] += s2 * w.z; a2[3] += s2 * w.w;
      }
#pragma unroll
      for (int e = 0; e < 4; ++e) {
        fs[kg * 96 + 0 + cq * 4 + e] = a0[e];
        fs[kg * 96 + 32 + cq * 4 + e] = a1[e];
        fs[kg * 96 + 64 + cq * 4 + e] = a2[e];
      }
      __syncthreads();
      if (tid < 96) {
        float s = 0;
        for (int g = 0; g < 32; ++g) s += fs[g * 96 + tid];
        const int v = tid >> 5, col = n0 + (tid & 31);
        s += p.in[I_BMOD][l * 3072 + col];
        ((float*)(p.ws + OFF_MOD))[(l * 3 + v) * 3072 + col] = s;
      }
      asm volatile("s_waitcnt vmcnt(0)" ::: "memory");
      __syncthreads();
      if (l == 0 && tid == 0) {
        __builtin_amdgcn_fence(__ATOMIC_RELEASE, "agent");
        asm volatile("s_waitcnt vmcnt(0)" ::: "memory");
        __hip_atomic_fetch_add((unsigned*)(p.ws + OFF_BAR) + MODCNT_WORD, 1u, __ATOMIC_RELAXED, __HIP_MEMORY_SCOPE_AGENT);
      }
    } else {
      int t = item - 192;
      const float* W; u16* Wt; int N;
      if (t < 640) { W = p.in[I_WINE]; Wt = (u16*)(p.ws + OFF_WIN0); N = 2560; }
      else if (t < 896) { t -= 640; W = p.in[I_WOUTE]; Wt = (u16*)(p.ws + OFF_WOUT0); N = 1024; }
      else if (t < 1920) { t -= 896; W = p.in[I_WINO]; Wt = (u16*)(p.ws + OFF_WIN1); N = 4096; }
      else { t -= 1920; W = p.in[I_WOUTO]; Wt = (u16*)(p.ws + OFF_WOUT1); N = 1024; }
      const int nt = N / 64;
      const int k0 = (t / nt) * 64, n0 = (t % nt) * 64;
#pragma unroll
      for (int i = 0; i < 4; ++i) {
        const int idx = tid + 256 * i;
        const int row = idx >> 4, c4 = idx & 15;
        const f32x4 wv_ = __builtin_nontemporal_load((const f32x4*)(W + (size_t)(k0 + row) * N + n0 + c4 * 4)); const float4 w = {wv_[0], wv_[1], wv_[2], wv_[3]};
        fs[row * 65 + c4 * 4 + 0] = w.x; fs[row * 65 + c4 * 4 + 1] = w.y;
        fs[row * 65 + c4 * 4 + 2] = w.z; fs[row * 65 + c4 * 4 + 3] = w.w;
      }
      __syncthreads();
#pragma unroll
      for (int i = 0; i < 2; ++i) {
        const int idx = tid + 256 * i;
        const int n = idx >> 3, kc = idx & 7;
        uint4 o;
        o.x = pack2(fs[(kc * 8 + 0) * 65 + n], fs[(kc * 8 + 1) * 65 + n]);
        o.y = pack2(fs[(kc * 8 + 2) * 65 + n], fs[(kc * 8 + 3) * 65 + n]);
        o.z = pack2(fs[(kc * 8 + 4) * 65 + n], fs[(kc * 8 + 5) * 65 + n]);
        o.w = pack2(fs[(kc * 8 + 6) * 65 + n], fs[(kc * 8 + 7) * 65 + n]);
        st16_wt(Wt + (size_t)(n0 + n) * 1024 + k0 + kc * 8, o);
      }
      __syncthreads();
    }
  }
}
DI void phase0(const Params& p, unsigned char* smem, bool fuse_h0) {
  const int tid = threadIdx.x;
  const int b = blockIdx.x, nb = gridDim.x;
  for (int item = b; item < 192; item += nb) prep_item(p, smem, item, tid);
  if (nb >= 384) {
    if (b < 192) { prep_item(p, smem, 192 + b, tid); prep_item(p, smem, 192 + 192 + b, tid); }
    else for (int t = 384 + (b - 192); t < 2176; t += nb - 192) prep_item(p, smem, 192 + t, tid);
  } else {
    for (int t = b; t < 2176; t += nb) prep_item(p, smem, 192 + t, tid);
  }
  const int gtid = blockIdx.x * 256 + tid, gsz = gridDim.x * 256;
  if (gtid < 64) ((int*)(p.ws + OFF_CNT))[gtid] = 0;
  float* tab = (float*)(p.ws + OFF_ROPE);
  for (int idx = gtid; idx < 1024 * 32; idx += gsz) {
    const int s = idx >> 5, i = idx & 31, which = i >> 4, fi = i & 15;
    const float pos = (float)(which ? (s & 63) : (s >> 6));
    const float freq = exp2f(-(float)fi * (13.287712379549449f / 16.0f));
    float tr = pos * freq * 0.15915494309189535f;
    tr = tr - floorf(tr);
    tab[s * 64 + which * 32 + fi] = __builtin_amdgcn_cosf(tr);
    tab[s * 64 + which * 32 + 16 + fi] = __builtin_amdgcn_sinf(tr);
  }
  for (int idx = gtid; idx < 2 * 256 * 128; idx += gsz) {
    const int b = idx >> 15, s = (idx >> 7) & 255, kvh = (idx >> 6) & 1, d = idx & 63;
    const size_t ko = ((size_t)(b * 2 + kvh) * 1280 + 1024 + s) * 64 + d;
    const size_t vo = ((size_t)(b * 2 + kvh) * 64 + d) * 1280 + 1024 + s;
    ((u16*)(p.ws + OFF_KSA))[ko] = f2bf(p.in[I_CAK][idx]);
    ((u16*)(p.ws + OFF_VSA))[vo] = f2bf(p.in[I_CAV][idx]);
    ((u16*)(p.ws + OFF_KSB))[ko] = f2bf(p.in[I_CBK][idx]);
    ((u16*)(p.ws + OFF_VSB))[vo] = f2bf(p.in[I_CBV][idx]);
  }
  for (int idx = gtid; idx < 2 * 256 * 1024; idx += gsz) {
    const int b = idx >> 18, s = (idx >> 10) & 255, col = idx & 1023;
    const int hh = col >> 6, d = col & 63, head = col >> 7, dv = col & 127;
    ((u16*)(p.ws + OFF_KSC))[((size_t)(b * 16 + hh) * 1280 + 1024 + s) * 64 + d] = f2bf(p.in[I_CCK][idx]);
    ((u16*)(p.ws + OFF_VSC))[((size_t)(b * 8 + head) * 128 + dv) * 1280 + 1024 + s] = f2bf(p.in[I_CCV][idx]);
  }
  if (fuse_h0) {
    if (tid == 0) {
      unsigned* mc = (unsigned*)(p.ws + OFF_BAR) + MODCNT_WORD;
      unsigned spins = 0;
      while (__hip_atomic_load(mc, __ATOMIC_RELAXED, __HIP_MEMORY_SCOPE_AGENT) < 96u && ++spins < (1u << 22)) __builtin_amdgcn_s_sleep(1);
      __builtin_amdgcn_fence(__ATOMIC_ACQUIRE, "agent");
      asm volatile("s_waitcnt vmcnt(0)" ::: "memory");
    }
    __syncthreads();
    phase_h0(p);
  }
}

template <bool FINAL>
DI void phase_ln(const Params& p) {
  const int lane = threadIdx.x & 63;
  const int gw = blockIdx.x * 4 + (threadIdx.x >> 6), nw = gridDim.x * 4;
  const int l = FINAL ? 1 : 0;
  const float* R = (const float*)(p.ws + OFF_R);
  const float* g = p.in[I_LNG] + l * 1024;
  const float* bb = p.in[I_LNB] + l * 1024;
  for (int row = gw; row < M_ALL; row += nw) {
    float4 v[4];
    float s = 0;
#pragma unroll
    for (int i = 0; i < 4; ++i) {
      v[i] = *(const float4*)(R + (size_t)row * 1024 + i * 256 + lane * 4);
      s += v[i].x + v[i].y + v[i].z + v[i].w;
    }
    const float mu = wave_sum(s) * (1.0f / 1024.0f);
    float q = 0;
#pragma unroll
    for (int i = 0; i < 4; ++i) {
      v[i].x -= mu; v[i].y -= mu; v[i].z -= mu; v[i].w -= mu;
      q += v[i].x * v[i].x + v[i].y * v[i].y + v[i].z * v[i].z + v[i].w * v[i].w;
    }
    const float rs = rsqrtf(wave_sum(q) * (1.0f / 1024.0f) + EPS);
#pragma unroll
    for (int i = 0; i < 4; ++i) {
      const int c = i * 256 + lane * 4;
      const float4 gg = *(const float4*)(g + c), be = *(const float4*)(bb + c);
      float4 y;
      y.x = v[i].x * rs * gg.x + be.x; y.y = v[i].y * rs * gg.y + be.y;
      y.z = v[i].z * rs * gg.z + be.z; y.w = v[i].w * rs * gg.w + be.w;
      if (FINAL) {
        st16_wt(p.out + (size_t)row * 1024 + c, y);
      } else {
        st16_wt((float*)(p.ws + OFF_X1) + (size_t)row * 1024 + c, y);
        const float* mv = (const float*)(p.ws + OFF_MOD) + (3 + modvec(row)) * 3072;
        const float4 sh = *(const float4*)(mv + c), sc = *(const float4*)(mv + 1024 + c);
        uint2 o;
        o.x = pack2(y.x * (1.f + sc.x) + sh.x, y.y * (1.f + sc.y) + sh.y);
        o.y = pack2(y.z * (1.f + sc.z) + sh.z, y.w * (1.f + sc.w) + sh.w);
        st8_wt((u16*)(p.ws + OFF_H) + (size_t)row * 1024 + c, o);
      }
    }
  }
}

DI void rope_T(const Params& p, f32x4 (&acc)[4][4], int rbase, int lane) {
  const float* tab = (const float*)(p.ws + OFF_ROPE);
  const int l15 = lane & 15, f0 = (lane >> 4) * 4;
#pragma unroll
  for (int mi = 0; mi < 4; ++mi) {
    const int s = (rbase + mi * 16 + l15 - M_CTX) & 1023;
    const float* t = tab + s * 64 + f0;
    const float4 cr = *(const float4*)(t), sr = *(const float4*)(t + 16), cc = *(const float4*)(t + 32), sc = *(const float4*)(t + 48);
    const float crv[4] = {cr.x, cr.y, cr.z, cr.w}, srv[4] = {sr.x, sr.y, sr.z, sr.w};
    const float ccv[4] = {cc.x, cc.y, cc.z, cc.w}, scv[4] = {sc.x, sc.y, sc.z, sc.w};
#pragma unroll
    for (int j = 0; j < 4; ++j) {
      const float x1 = acc[0][mi][j], x2 = acc[1][mi][j], y1 = acc[2][mi][j], y2 = acc[3][mi][j];
      acc[0][mi][j] = x1 * crv[j] - x2 * srv[j]; acc[1][mi][j] = x1 * srv[j] + x2 * crv[j];
      acc[2][mi][j] = y1 * ccv[j] - y2 * scv[j]; acc[3][mi][j] = y1 * scv[j] + y2 * ccv[j];
    }
  }
}
DI void rms_T(f32x4 (&acc)[4][4], const float* w, int lane) {
  const int f0 = (lane >> 4) * 4;
  float4 wv[4];
#pragma unroll
  for (int ni = 0; ni < 4; ++ni) wv[ni] = *(const float4*)(w + ni * 16 + f0);
#pragma unroll
  for (int mi = 0; mi < 4; ++mi) {
    float ss = 0;
#pragma unroll
    for (int ni = 0; ni < 4; ++ni)
#pragma unroll
      for (int j = 0; j < 4; ++j) ss += acc[ni][mi][j] * acc[ni][mi][j];
    ss += __shfl_xor(ss, 16);
    ss += __shfl_xor(ss, 32);
    const float r = rsqrtf(ss * (1.0f / 64.0f) + EPS);
#pragma unroll
    for (int ni = 0; ni < 4; ++ni) {
      acc[ni][mi][0] *= r * wv[ni].x; acc[ni][mi][1] *= r * wv[ni].y;
      acc[ni][mi][2] *= r * wv[ni].z; acc[ni][mi][3] *= r * wv[ni].w;
    }
  }
}
DI void store_bf16_T(f32x4 (&acc)[4][4], u16* dst, size_t ld, int lane, float scale) {
  const int l15 = lane & 15, f0 = (lane >> 4) * 4;
#pragma unroll
  for (int mi = 0; mi < 4; ++mi)
#pragma unroll
    for (int ni = 0; ni < 4; ++ni) {
      uint2 o;
      o.x = pack2(acc[ni][mi][0] * scale, acc[ni][mi][1] * scale);
      o.y = pack2(acc[ni][mi][2] * scale, acc[ni][mi][3] * scale);
      *(uint2*)(dst + (size_t)(mi * 16 + l15) * ld + ni * 16 + f0) = o;
    }
}
DI void store_f32_T(f32x4 (&acc)[4][4], float* dst, size_t ld, int lane) {
  const int l15 = lane & 15, f0 = (lane >> 4) * 4;
#pragma unroll
  for (int mi = 0; mi < 4; ++mi)
#pragma unroll
    for (int ni = 0; ni < 4; ++ni) {
      float4 o = {acc[ni][mi][0], acc[ni][mi][1], acc[ni][mi][2], acc[ni][mi][3]};
      *(float4*)(dst + (size_t)(mi * 16 + l15) * ld + ni * 16 + f0) = o;
    }
}
DI void silu_tile(f32x4 (&acc)[4][4]) {
#pragma unroll
  for (int a = 0; a < 4; ++a)
#pragma unroll
    for (int b = 0; b < 4; ++b)
#pragma unroll
      for (int j = 0; j < 4; ++j) acc[a][b][j] = silu(acc[a][b][j]);
}
DI void stage_bf16_T(f32x4 (&acc)[4][4], unsigned char* stg, u16* dst, size_t ld, int lane, float scale) {
  const int l15 = lane & 15, g = lane >> 4;
#pragma unroll
  for (int mi = 0; mi < 4; ++mi)
#pragma unroll
    for (int ni = 0; ni < 4; ++ni) {
      uint2 o;
      o.x = pack2(acc[ni][mi][0] * scale, acc[ni][mi][1] * scale);
      o.y = pack2(acc[ni][mi][2] * scale, acc[ni][mi][3] * scale);
      *(uint2*)(stg + (mi * 16 + l15) * 144 + ni * 32 + g * 8) = o;
    }
#pragma unroll
  for (int i = 0; i < 8; ++i) {
    const int id = lane + 64 * i, row = id >> 3, c = id & 7;
    const uint4 v = *(const uint4*)(stg + row * 144 + c * 16);
    st16_wt(dst + (size_t)row * ld + c * 8, v);
  }
}
DI void stage_f32_half_T(f32x4 (&acc)[4][4], unsigned char* stg, int half, int lane) {
  const int l15 = lane & 15, g = lane >> 4;
#pragma unroll
  for (int m2 = 0; m2 < 2; ++m2)
#pragma unroll
    for (int ni = 0; ni < 4; ++ni) {
      const int mi = half * 2 + m2;
      float4 o = {acc[ni][mi][0], acc[ni][mi][1], acc[ni][mi][2], acc[ni][mi][3]};
      *(float4*)(stg + (m2 * 16 + l15) * 272 + (ni * 16 + g * 4) * 4) = o;
    }
}
DI void stage_f32_T(f32x4 (&acc)[4][4], unsigned char* stg, float* dst, size_t ld, int lane) {
#pragma unroll
  for (int half = 0; half < 2; ++half) {
    stage_f32_half_T(acc, stg, half, lane);
#pragma unroll
    for (int i = 0; i < 8; ++i) {
      const int id = lane + 64 * i, row = id >> 4, c = id & 15;
      const float4 v = *(const float4*)(stg + row * 272 + c * 16);
      st16_wt(dst + (size_t)(half * 32 + row) * ld + c * 4, v);
    }
  }
}
DI void store_f32_N(f32x4 (&acc)[4][4], float* dst, size_t ld, int lane) {
  const int c = lane & 15, rq = (lane >> 4) * 4;
#pragma unroll
  for (int mi = 0; mi < 4; ++mi)
#pragma unroll
    for (int j = 0; j < 4; ++j)
#pragma unroll
      for (int ni = 0; ni < 4; ++ni) dst[(size_t)(mi * 16 + rq + j) * ld + ni * 16 + c] = acc[mi][ni][j];
}
DI void store_tr_N(f32x4 (&acc)[4][4], u16* dst, size_t ld, int lane) {
  const int c = lane & 15, rq = (lane >> 4) * 4;
#pragma unroll
  for (int mi = 0; mi < 4; ++mi)
#pragma unroll
    for (int ni = 0; ni < 4; ++ni) {
      uint2 o;
      o.x = pack2(acc[mi][ni][0], acc[mi][ni][1]);
      o.y = pack2(acc[mi][ni][2], acc[mi][ni][3]);
      st8_wt(dst + (size_t)(ni * 16 + c) * ld + mi * 16 + rq, o);
    }
}
DI void store_k(const Params& p, f32x4 (&acc)[4][4], unsigned char* stg, int rbase, int lane, int nh, int hidx, size_t off_kc, size_t off_ks) {
  if (rbase < M_CTX) {
    const int b = rbase >> 8, s0 = rbase & 255;
    stage_bf16_T(acc, stg, (u16*)(p.ws + off_kc) + ((size_t)(b * nh + hidx) * 256 + s0) * 64, 64, lane, 1.0f);
  } else {
    const int r = rbase - M_CTX, b = r >> 10, s0 = r & 1023;
    stage_bf16_T(acc, stg, (u16*)(p.ws + off_ks) + ((size_t)(b * nh + hidx) * 1280 + s0) * 64, 64, lane, 1.0f);
  }
}
DI void store_v(const Params& p, f32x4 (&acc)[4][4], int rbase, int lane, int nh, int hidx, int dvh, int dv0, size_t off_vc, size_t off_vs) {
  if (rbase < M_CTX) {
    const int b = rbase >> 8, s0 = rbase & 255;
    store_tr_N(acc, (u16*)(p.ws + off_vc) + ((size_t)(b * nh + hidx) * dvh + dv0) * 256 + s0, 256, lane);
  } else {
    const int r = rbase - M_CTX, b = r >> 10, s0 = r & 1023;
    store_tr_N(acc, (u16*)(p.ws + off_vs) + ((size_t)(b * nh + hidx) * dvh + dv0) * 1280 + s0, 1280, lane);
  }
}

enum { EPI_IN0 = 0, EPI_OUT0 = 1, EPI_IN1 = 2, EPI_OUT1 = 3 };

template <int EPI>
DI bool is_v_tile(int n0) {
  if (EPI == EPI_IN0) return n0 == 640 || n0 == 1920;
  if (EPI == EPI_IN1) return n0 >= 2048 && n0 < 3072;
  return false;
}

template <int EPI>
DI void epilogue(const Params& p, f32x4 (&acc)[4][4], unsigned char* stg, int rbase, int cb, int lane) {
  const bool smp = rbase >= M_CTX;
  u16* Q = (u16*)(p.ws + OFF_Q);
  u16* G = (u16*)(p.ws + OFF_G);
  if (EPI == EPI_IN0) {
    if (cb < 512) {
      rms_T(acc, p.in[I_QNA], lane);
      if (smp) rope_T(p, acc, rbase, lane);
      stage_bf16_T(acc, stg, Q + (size_t)rbase * 1024 + cb, 1024, lane, QSCALE);
    } else if (cb < 640) {
      const int kvh = (cb - 512) >> 6;
      rms_T(acc, p.in[I_KNA], lane);
      if (!smp) stage_f32_T(acc, stg, p.out + O_AK + (size_t)rbase * 128 + kvh * 64, 128, lane);
      else rope_T(p, acc, rbase, lane);
      store_k(p, acc, stg, rbase, lane, 2, kvh, OFF_KCA, OFF_KSA);
    } else if (cb < 768) {
      const int kvh = (cb - 640) >> 6;
      if (!smp) store_f32_N(acc, p.out + O_AV + (size_t)rbase * 128 + kvh * 64, 128, lane);
      store_v(p, acc, rbase, lane, 2, kvh, 64, 0, OFF_VCA, OFF_VSA);
    } else if (cb < 1280) {
      silu_tile(acc);
      stage_bf16_T(acc, stg, G + (size_t)rbase * 1024 + (cb - 768), 1024, lane, 1.0f);
    } else if (cb < 1792) {
      if (smp) rope_T(p, acc, rbase, lane);
      stage_bf16_T(acc, stg, Q + (size_t)rbase * 1024 + 512 + (cb - 1280), 1024, lane, QSCALE);
    } else if (cb < 1920) {
      const int kvh = (cb - 1792) >> 6;
      if (!smp) stage_f32_T(acc, stg, p.out + O_BK + (size_t)rbase * 128 + kvh * 64, 128, lane);
      else rope_T(p, acc, rbase, lane);
      store_k(p, acc, stg, rbase, lane, 2, kvh, OFF_KCB, OFF_KSB);
    } else if (cb < 2048) {
      const int kvh = (cb - 1920) >> 6;
      if (!smp) store_f32_N(acc, p.out + O_BV + (size_t)rbase * 128 + kvh * 64, 128, lane);
      store_v(p, acc, rbase, lane, 2, kvh, 64, 0, OFF_VCB, OFF_VSB);
    } else {
      silu_tile(acc);
      stage_bf16_T(acc, stg, G + (size_t)rbase * 1024 + 512 + (cb - 2048), 1024, lane, 1.0f);
    }
  } else if (EPI == EPI_IN1) {
    if (cb < 1024) {
      if (smp) rope_T(p, acc, rbase, lane);
      stage_bf16_T(acc, stg, Q + (size_t)rbase * 1024 + cb, 1024, lane, QSCALE);
    } else if (cb < 2048) {
      const int hh = (cb - 1024) >> 6;
      if (!smp) stage_f32_T(acc, stg, p.out + O_CK + (size_t)rbase * 1024 + (cb - 1024), 1024, lane);
      else rope_T(p, acc, rbase, lane);
      store_k(p, acc, stg, rbase, lane, 16, hh, OFF_KCC, OFF_KSC);
    } else if (cb < 3072) {
      const int head = (cb - 2048) >> 7, dv0 = (cb - 2048) & 127;
      if (!smp) store_f32_N(acc, p.out + O_CV + (size_t)rbase * 1024 + (cb - 2048), 1024, lane);
      store_v(p, acc, rbase, lane, 8, head, 128, dv0, OFF_VCC, OFF_VSC);
    } else {
      silu_tile(acc);
      stage_bf16_T(acc, stg, G + (size_t)rbase * 1024 + (cb - 3072), 1024, lane, 1.0f);
    }
  } else {
    const int l = (EPI == EPI_OUT0) ? 0 : 1;
    const float* gate = (const float*)(p.ws + OFF_MOD) + (l * 3 + modvec(rbase)) * 3072 + 2048 + cb;
    const float* xres = ((EPI == EPI_OUT0) ? xrow(p, rbase) : (const float*)(p.ws + OFF_X1) + (size_t)rbase * 1024) + cb;
    float* R = (float*)(p.ws + OFF_R) + (size_t)rbase * 1024 + cb;
    const int c = lane & 15;
    const float4 gv = *(const float4*)(gate + c * 4);
#pragma unroll
    for (int half = 0; half < 2; ++half) {
      stage_f32_half_T(acc, stg, half, lane);
#pragma unroll
      for (int i = 0; i < 8; ++i) {
        const int row = (lane >> 4) + 4 * i;
        const float4 a = *(const float4*)(stg + row * 272 + c * 16);
        const size_t o = (size_t)(half * 32 + row) * 1024 + c * 4;
        const float4 x = *(const float4*)(xres + o);
        float4 r;
        r.x = ALPHA * x.x + gv.x * a.x; r.y = ALPHA * x.y + gv.y * a.y;
        r.z = ALPHA * x.z + gv.z * a.z; r.w = ALPHA * x.w + gv.w * a.w;
        st16_wt(R + o, r);
      }
    }
  }
}

DI void gemm_stage(const u16* ag, const u16* bg, u16* sa, u16* sb, int tid, int k0) {
#pragma unroll
  for (int i = 0; i < 4; ++i) {
    const int id = tid + 256 * i;
    const int row = id >> 3, c = (id & 7) ^ ((row >> 1) & 7);
    __builtin_amdgcn_global_load_lds((const unsigned*)(ag + (size_t)row * 1024 + k0 + c * 8), (unsigned*)(sa + id * 8), 16, 0, 0);
    __builtin_amdgcn_global_load_lds((const unsigned*)(bg + (size_t)row * 1024 + k0 + c * 8), (unsigned*)(sb + id * 8), 16, 0, 0);
  }
}

template <bool SWAP>
DI void gemm_mainloop(const u16* ag, const u16* bg, u16* sA, u16* sB, int tid, int wm, int wn, f32x4 (&acc)[4][4]) {
  const int lane = tid & 63;
#pragma unroll
  for (int a = 0; a < 4; ++a)
#pragma unroll
    for (int b = 0; b < 4; ++b) acc[a][b] = f32x4{0.f, 0.f, 0.f, 0.f};
  gemm_stage(ag, bg, sA, sB, tid, 0);
  __syncthreads();
  const int ra = wm * 64 + (lane & 15), rb = wn * 64 + (lane & 15);
  const int swa = (ra >> 1) & 7, swb = (rb >> 1) & 7;
  const int q = lane >> 4;
#pragma unroll 2
  for (int kt = 0; kt < 16; ++kt) {
    const int cur = kt & 1;
    if (kt + 1 < 16) gemm_stage(ag, bg, sA + (cur ^ 1) * 8192, sB + (cur ^ 1) * 8192, tid, (kt + 1) * 64);
    const u16* a_s = sA + cur * 8192 + ra * 64;
    const u16* b_s = sB + cur * 8192 + rb * 64;
#pragma unroll
    for (int ks = 0; ks < 2; ++ks) {
      bf16x8 af[4], bfr[4];
#pragma unroll
      for (int mi = 0; mi < 4; ++mi) af[mi] = *(const bf16x8*)(a_s + mi * 16 * 64 + (((ks * 4 + q) ^ swa) * 8));
#pragma unroll
      for (int ni = 0; ni < 4; ++ni) bfr[ni] = *(const bf16x8*)(b_s + ni * 16 * 64 + (((ks * 4 + q) ^ swb) * 8));
#pragma unroll
      for (int a = 0; a < 4; ++a)
#pragma unroll
        for (int b = 0; b < 4; ++b) {
          if (SWAP) acc[a][b] = MFMA16(bfr[a], af[b], acc[a][b]);
          else acc[a][b] = MFMA16(af[a], bfr[b], acc[a][b]);
        }
    }
    __syncthreads();
  }
}

template <int EPI>
DI void gemm_phase(const Params& p, unsigned char* smem, const u16* A, const u16* Wt, int N, bool do_epi = true, bool fuse_ln = false) {
  const int tid = threadIdx.x, lane = tid & 63, wave = tid >> 6;
  const int wm = wave >> 1, wn = wave & 1;
  const int NT = N >> 7;
  const int ntiles = 48 * NT;
  u16* sA = (u16*)smem;
  u16* sB = sA + 2 * 8192;
#if GEMM_SKEW
  if (blockIdx.x >= (gridDim.x >> 1)) { for (int i = 0; i < GEMM_SKEW; ++i) __builtin_amdgcn_s_sleep(127); }
#endif
  const bool xcd_map = (gridDim.x & 7) == 0;
  const int nslot = xcd_map ? (gridDim.x >> 3) : gridDim.x;
  const int slot = xcd_map ? (blockIdx.x >> 3) : blockIdx.x;
  const int nloc = xcd_map ? 6 * NT : ntiles;
  for (int j = slot; j < nloc; j += nslot) {
    int tm, tn;
    if (xcd_map) { tn = j / 6; tm = (blockIdx.x & 7) * 6 + (j - tn * 6); }
    else { tm = j / NT; tn = j - tm * NT; }
    const int m0 = tm * 128, n0 = tn * 128;
    f32x4 acc[4][4];
    const u16* ag = A + (size_t)m0 * 1024;
    const u16* bg = Wt + (size_t)n0 * 1024;
    if (is_v_tile<EPI>(n0)) gemm_mainloop<false>(ag, bg, sA, sB, tid, wm, wn, acc);
    else gemm_mainloop<true>(ag, bg, sA, sB, tid, wm, wn, acc);
    int lane_e = lane;
    asm volatile("" : "+v"(lane_e));
    if (do_epi && fuse_ln && (EPI == EPI_OUT0 || EPI == EPI_OUT1))
      epilogue_ln<(EPI == EPI_OUT1) ? EPI_OUT1 : EPI_OUT0>(p, acc, smem + wave * 9216, m0 + wm * 64, n0 + wn * 64, lane_e, tm, tn * 2 + wn);
    else if (do_epi) epilogue<EPI>(p, acc, smem + wave * 9216, m0 + wm * 64, n0 + wn * 64, lane_e);
    else if (p.ph_hi > 1000) {
      float s = 0;
      for (int a = 0; a < 4; ++a) for (int b = 0; b < 4; ++b) s += acc[a][b][0] + acc[a][b][1] + acc[a][b][2] + acc[a][b][3];
      p.out[lane_e] = s;
    }
    __syncthreads();
  }
}

DI unsigned band_ld(unsigned* p) { return __hip_atomic_load(p, __ATOMIC_RELAXED, __HIP_MEMORY_SCOPE_AGENT); }
template <int EPI>
DI void epilogue_ln(const Params& p, f32x4 (&acc)[4][4], unsigned char* stg, int rbase, int cb, int lane, int tm, int slot16) {
  constexpr int l = (EPI == EPI_OUT0) ? 0 : 1;
  const int l15 = lane & 15, g = lane >> 4, f0 = g * 4;
  const float* mod = (const float*)(p.ws + OFF_MOD);
  const int mv = modvec(rbase);
  {
    const float* gate = mod + (l * 3 + mv) * 3072 + 2048 + cb + f0;
    const float* xres = ((EPI == EPI_OUT0) ? xrow(p, rbase) : (const float*)(p.ws + OFF_X1) + (size_t)rbase * 1024) + cb + f0;
    float4 gv[4];
#pragma unroll
    for (int ni = 0; ni < 4; ++ni) gv[ni] = *(const float4*)(gate + ni * 16);
#pragma unroll
    for (int mi = 0; mi < 4; ++mi)
#pragma unroll
      for (int ni = 0; ni < 4; ++ni) {
        const float4 x = *(const float4*)(xres + (size_t)(mi * 16 + l15) * 1024 + ni * 16);
        acc[ni][mi][0] = ALPHA * x.x + gv[ni].x * acc[ni][mi][0]; acc[ni][mi][1] = ALPHA * x.y + gv[ni].y * acc[ni][mi][1];
        acc[ni][mi][2] = ALPHA * x.z + gv[ni].z * acc[ni][mi][2]; acc[ni][mi][3] = ALPHA * x.w + gv[ni].w * acc[ni][mi][3];
      }
  }
  unsigned long long* part = (unsigned long long*)(p.ws + OFF_PART);
#pragma unroll
  for (int mi = 0; mi < 4; ++mi) {
    float s = 0.f, q = 0.f;
#pragma unroll
    for (int ni = 0; ni < 4; ++ni)
#pragma unroll
      for (int j = 0; j < 4; ++j) { s += acc[ni][mi][j]; q += acc[ni][mi][j] * acc[ni][mi][j]; }
    s += __shfl_xor(s, 16); s += __shfl_xor(s, 32);
    q += __shfl_xor(q, 16); q += __shfl_xor(q, 32);
    if (g == 0) st8_wt(part + (size_t)(rbase + mi * 16 + l15) * 16 + slot16, uint2{__float_as_uint(s), __float_as_uint(q)});
  }
  asm volatile("s_waitcnt vmcnt(0)" ::: "memory");
  __syncthreads();
  if (threadIdx.x == 0) {
    unsigned* bc = (unsigned*)(p.ws + OFF_BAR) + BANDCNT_WORD + l * 48 + tm;
    __hip_atomic_fetch_add(bc, 1u, __ATOMIC_RELAXED, __HIP_MEMORY_SCOPE_AGENT);
    unsigned spins = 0;
    while (band_ld(bc) < 8u && ++spins < (1u << 22)) __builtin_amdgcn_s_sleep(1);
    __builtin_amdgcn_fence(__ATOMIC_ACQUIRE, "agent");
    asm volatile("s_waitcnt vmcnt(0)" ::: "memory");
  }
  __syncthreads();
  const float* lg = p.in[I_LNG] + l * 1024 + cb + f0;
  const float* lb = p.in[I_LNB] + l * 1024 + cb + f0;
  float4 gam[4], bet[4];
#pragma unroll
  for (int ni = 0; ni < 4; ++ni) { gam[ni] = *(const float4*)(lg + ni * 16); bet[ni] = *(const float4*)(lb + ni * 16); }
#pragma unroll
  for (int mi = 0; mi < 4; ++mi) {
    unsigned long long* pr = part + (size_t)(rbase + mi * 16 + l15) * 16 + g * 4;
    float s = 0.f, q = 0.f;
#pragma unroll
    for (int k = 0; k < 4; ++k) {
      const unsigned long long v = __hip_atomic_load(pr + k, __ATOMIC_RELAXED, __HIP_MEMORY_SCOPE_AGENT);
      s += __uint_as_float((unsigned)v); q += __uint_as_float((unsigned)(v >> 32));
    }
    s += __shfl_xor(s, 16); s += __shfl_xor(s, 32);
    q += __shfl_xor(q, 16); q += __shfl_xor(q, 32);
    const float mean = s * (1.0f / 1024.0f);
    const float var = fmaxf(q * (1.0f / 1024.0f) - mean * mean, 0.f);
    const float rstd = rsqrtf(var + EPS);
#pragma unroll
    for (int ni = 0; ni < 4; ++ni) {
      acc[ni][mi][0] = (acc[ni][mi][0] - mean) * rstd * gam[ni].x + bet[ni].x; acc[ni][mi][1] = (acc[ni][mi][1] - mean) * rstd * gam[ni].y + bet[ni].y;
      acc[ni][mi][2] = (acc[ni][mi][2] - mean) * rstd * gam[ni].z + bet[ni].z; acc[ni][mi][3] = (acc[ni][mi][3] - mean) * rstd * gam[ni].w + bet[ni].w;
    }
  }
  if (EPI == EPI_OUT0) {
    stage_f32_T(acc, stg, (float*)(p.ws + OFF_X1) + (size_t)rbase * 1024 + cb, 1024, lane);
    const float* m1 = mod + (3 + mv) * 3072 + cb + f0;
#pragma unroll
    for (int ni = 0; ni < 4; ++ni) {
      const float4 sh = *(const float4*)(m1 + ni * 16), sc = *(const float4*)(m1 + 1024 + ni * 16);
#pragma unroll
      for (int mi = 0; mi < 4; ++mi) {
        acc[ni][mi][0] = acc[ni][mi][0] * (1.f + sc.x) + sh.x; acc[ni][mi][1] = acc[ni][mi][1] * (1.f + sc.y) + sh.y;
        acc[ni][mi][2] = acc[ni][mi][2] * (1.f + sc.z) + sh.z; acc[ni][mi][3] = acc[ni][mi][3] * (1.f + sc.w) + sh.w;
      }
    }
    stage_bf16_T(acc, stg, (u16*)(p.ws + OFF_H) + (size_t)rbase * 1024 + cb, 1024, lane, 1.0f);
  } else {
    stage_f32_T(acc, stg, p.out + (size_t)rbase * 1024 + cb, 1024, lane);
  }
}

DI void glds16_asm(const void* gsrc, unsigned lds_dst) {
  unsigned keep;
  asm volatile("s_mov_b32 %0, m0\n\ts_mov_b32 m0, %2\n\ts_nop 0\n\tglobal_load_lds_dwordx4 %1, off\n\ts_mov_b32 m0, %0"
               : "=&s"(keep) : "v"(gsrc), "s"(lds_dst) : "memory");
}
template <int LAYER>
DI void attn_issue(unsigned st, const u16* Kg0, const u16* Kg1, const u16* Vg, int vs, int key0, int tid) {
  const unsigned wb = __builtin_amdgcn_readfirstlane(st + (unsigned)(tid >> 6) * 1024u);
  if (LAYER == 0) {
#pragma unroll
    for (int i = 0; i < 2; ++i) {
      const int id = tid + 256 * i, row = id >> 3, c = (id & 7) ^ ((row >> 1) & 7);
      glds16_asm(Kg0 + (size_t)(key0 + row) * 64 + c * 8, wb + i * 4096);
      glds16_asm(Vg + (size_t)row * vs + key0 + c * 8, wb + 8192 + i * 4096);
    }
  } else {
    {
      const int id = tid, row = id >> 3, c = (id & 7) ^ ((row >> 1) & 7);
      glds16_asm(Kg0 + (size_t)(key0 + row) * 64 + c * 8, wb);
      glds16_asm(Kg1 + (size_t)(key0 + row) * 64 + c * 8, wb + 4096);
    }
#pragma unroll
    for (int i = 0; i < 2; ++i) {
      const int id = tid + 256 * i, row = id >> 2, c = (id & 3) ^ ((row >> 2) & 3);
      glds16_asm(Vg + (size_t)row * vs + key0 + c * 8, wb + 8192 + i * 4096);
    }
  }
}

template <int LAYER>
DI void flash_lds(const u16* Qp, unsigned char* ring, const u16* Kg0, const u16* Kg1, const u16* Vg, int vs, int kmap,
                  int tb1, int te1, int tb2, int te2, bool use_mask, int qpos0, float m_init, float l_init,
                  f32x16 (&O)[LAYER ? 4 : 2], float& l_out) {
  constexpr int DV = LAYER ? 128 : 64;
  constexpr int NSUB = LAYER ? 1 : 2;
  constexpr int KS = 32 * NSUB;
  const int tid = threadIdx.x, lane = tid & 63, r = lane & 31, h = lane >> 5;
  bf16x8 qf[4];
#pragma unroll
  for (int ks = 0; ks < 4; ++ks) qf[ks] = *(const bf16x8*)(Qp + (size_t)r * 1024 + ks * 16 + 8 * h);
#pragma unroll
  for (int d = 0; d < DV / 32; ++d)
#pragma unroll
    for (int i = 0; i < 16; ++i) O[d][i] = 0.f;
  float m = m_init;
  const f32x16 zero16 = {0.f, 0.f, 0.f, 0.f, 0.f, 0.f, 0.f, 0.f, 0.f, 0.f, 0.f, 0.f, 0.f, 0.f, 0.f, 0.f};
  f32x16 L = zero16;
  L[0] = l_init;
  const short one_bf = (r == 0 || r == 4) ? (short)0x3F80 : (short)0;
  const bf16x8 onesf = {one_bf, one_bf, one_bf, one_bf, one_bf, one_bf, one_bf, one_bf};
  const int pr = (r & 0x13) | ((r & 4) << 1) | ((r & 8) >> 1);
  const int n1 = te1 - tb1, ntot = n1 + (te2 - tb2);
  const int koff = (LAYER ? kmap * 4096 : 0) + pr * 128;
  const int ksw = (pr >> 1) & 7;
  const int voff = 8192 + (LAYER ? r * 64 : r * 128);
  const int vsw = LAYER ? ((r >> 2) & 3) : ((r >> 1) & 7);
  asm volatile("" : "+v"(qf[0]), "+v"(qf[1]), "+v"(qf[2]), "+v"(qf[3]));
  asm volatile("s_waitcnt vmcnt(0)" ::: "memory");
#define TKEY(it_) (((it_) < n1 ? tb1 + (it_) : tb2 + ((it_) - n1)) * KS)
  const unsigned ring_lds = (unsigned)(size_t)ring;
  attn_issue<LAYER>(ring_lds, Kg0, Kg1, Vg, vs, TKEY(0), tid);
  if (ntot > 1) attn_issue<LAYER>(ring_lds + 16384, Kg0, Kg1, Vg, vs, TKEY(1), tid);
  if (ntot > 2) attn_issue<LAYER>(ring_lds + 32768, Kg0, Kg1, Vg, vs, TKEY(2), tid);
  for (int it = 0; it < ntot; ++it) {
    const int rem = ntot - 1 - it;
    if (rem >= 2) asm volatile("s_waitcnt vmcnt(8)" ::: "memory");
    else if (rem == 1) asm volatile("s_waitcnt vmcnt(4)" ::: "memory");
    else asm volatile("s_waitcnt vmcnt(0)" ::: "memory");
    __builtin_amdgcn_s_barrier();
    if (it + 3 < ntot) attn_issue<LAYER>(ring_lds + ((it + 3) & 3) * 16384, Kg0, Kg1, Vg, vs, TKEY(it + 3), tid);
    const unsigned char* st = ring + (it & 3) * 16384;
    const int key0 = TKEY(it);
    f32x16 S[NSUB];
#pragma unroll
    for (int u = 0; u < NSUB; ++u) {
      bf16x8 kf[4];
#pragma unroll
      for (int ks = 0; ks < 4; ++ks) kf[ks] = *(const bf16x8*)(st + koff + u * 4096 + (((ks * 2 + h) ^ ksw) * 16));
      S[u] = MFMA32(kf[0], qf[0], zero16);
#pragma unroll
      for (int ks = 1; ks < 4; ++ks) S[u] = MFMA32(kf[ks], qf[ks], S[u]);
    }
    if (use_mask && it < n1 && !(key0 >= qpos0 + 31 - 128 && key0 + KS - 1 <= qpos0 + 128)) {
      const int q = qpos0 + r;
#pragma unroll
      for (int u = 0; u < NSUB; ++u)
#pragma unroll
        for (int i = 0; i < 16; ++i) {
          const int key = key0 + 32 * u + (i & 3) + 4 * ((i >> 2) & 1) + 8 * h + 16 * (i >> 3);
          const int dlt = key - q;
          S[u][i] = (dlt <= 128 && dlt >= -128) ? S[u][i] : -1e30f;
        }
    }
    float mx = S[0][0];
#pragma unroll
    for (int u = 0; u < NSUB; ++u)
#pragma unroll
      for (int i = 0; i < 16; ++i) mx = fmaxf(mx, S[u][i]);
    {
      const unsigned mu = __float_as_uint(mx);
      const auto sw = __builtin_amdgcn_permlane32_swap(mu, mu, false, false);
      mx = fmaxf(__uint_as_float(sw[0]), __uint_as_float(sw[1]));
    }
    const float mn = fmaxf(m, mx);
    if (__builtin_amdgcn_ballot_w64(mn != m) != 0) {
      const float alpha = exp2f_fast(m - mn);
#pragma unroll
      for (int d = 0; d < DV / 32; ++d)
#pragma unroll
        for (int i = 0; i < 16; ++i) O[d][i] *= alpha;
      L[0] *= alpha;
    }
    m = mn;
    const float nm = -mn;
#pragma unroll
    for (int u = 0; u < NSUB; ++u) {
      S[u] = S[u] + nm;
#pragma unroll
      for (int i = 0; i < 16; ++i) S[u][i] = exp2f_fast(S[u][i]);
    }
#pragma unroll
    for (int u = 0; u < NSUB; ++u) {
      bf16x8 pf[2];
#pragma unroll
      for (int s = 0; s < 2; ++s) {
        uint4 w;
        w.x = pack2(S[u][8 * s + 0], S[u][8 * s + 1]); w.y = pack2(S[u][8 * s + 2], S[u][8 * s + 3]);
        w.z = pack2(S[u][8 * s + 4], S[u][8 * s + 5]); w.w = pack2(S[u][8 * s + 6], S[u][8 * s + 7]);
        pf[s] = __builtin_bit_cast(bf16x8, w);
      }
#pragma unroll
      for (int s = 0; s < 2; ++s) L = MFMA32(onesf, pf[s], L);
#pragma unroll
      for (int d = 0; d < DV / 32; ++d)
#pragma unroll
        for (int s = 0; s < 2; ++s) {
          const bf16x8 vf = *(const bf16x8*)(st + voff + d * 32 * (LAYER ? 64 : 128) + (((4 * u + 2 * s + h) ^ vsw) * 16));
          O[d] = MFMA32(vf, pf[s], O[d]);
        }
    }
  }
#undef TKEY
  l_out = L[0];
}

DI void attn0_phase(const Params& p, unsigned char* smem, int cidx) {
  const int tid = threadIdx.x, lane = tid & 63, wave = tid >> 6;
  int* cnt = (int*)(p.ws + OFF_CNT) + cidx;
  int* s_item = (int*)(smem + 65536);
  const u16* Q = (const u16*)(p.ws + OFF_Q);
  const u16* G = (const u16*)(p.ws + OFF_G);
  u16* AO = (u16*)(p.ws + OFF_AO);
  for (int round = 0;; ++round) {
    if (tid == 0) *s_item = round == 0 ? (int)blockIdx.x : (int)gridDim.x + atomicAdd(cnt, 1);
    __syncthreads();
    const int item = *s_item;
    __syncthreads();
    if (item >= 768) break;
    int br, row0, head, vs, tb1, te1, tb2 = 0, te2 = 0, qpos0 = 0;
    bool use_mask = false;
    const u16 *Kp, *Vp;
    if (item < 256) {
      br = item >> 7;
      const int r = item & 127, b = r >> 6, kvh = (r >> 5) & 1, qb = r & 31;
      head = kvh * 4 + wave;
      row0 = M_CTX + b * 1024 + qb * 32;
      Kp = (const u16*)(p.ws + (br ? OFF_KSB : OFF_KSA)) + (size_t)(b * 2 + kvh) * 1280 * 64;
      Vp = (const u16*)(p.ws + (br ? OFF_VSB : OFF_VSA)) + (size_t)(b * 2 + kvh) * 64 * 1280;
      vs = 1280;
      if (br == 0) { tb1 = 0; te1 = 20; }
      else {
        const int q0 = qb * 32;
        tb1 = q0 >= 128 ? (q0 - 128) >> 6 : 0;
        te1 = ((q0 + 159) >> 6) + 1; if (te1 > 16) te1 = 16;
        tb2 = 16; te2 = 20; use_mask = true; qpos0 = q0;
      }
    } else {
      int r = item - 256;
      br = r >> 8; r &= 255;
      const int b = r >> 4, kvh = (r >> 3) & 1, qb = r & 7;
      head = kvh * 4 + wave;
      row0 = b * 256 + qb * 32;
      Kp = (const u16*)(p.ws + (br ? OFF_KCB : OFF_KCA)) + (size_t)(b * 2 + kvh) * 256 * 64;
      Vp = (const u16*)(p.ws + (br ? OFF_VCB : OFF_VCA)) + (size_t)(b * 2 + kvh) * 64 * 256;
      vs = 256; tb1 = 0; te1 = 4;
    }
    const float m_init = br ? p.in[I_SINK][head] * LOG2E : -1e30f;
    const float l_init = br ? 1.0f : 0.0f;
    const int col0 = br * 512 + head * 64;
    f32x16 O[2];
    float l;
    flash_lds<0>(Q + (size_t)row0 * 1024 + col0, smem, Kp, Kp, Vp, vs, 0, tb1, te1, tb2, te2, use_mask, qpos0, m_init, l_init, O, l);
    const float inv = 1.0f / l;
    const int row = row0 + (lane & 31), h = lane >> 5;
#pragma unroll
    for (int d = 0; d < 2; ++d)
#pragma unroll
      for (int g = 0; g < 4; ++g) {
        const size_t o = (size_t)row * 1024 + col0 + d * 32 + 8 * g + 4 * h;
        const uint2 gv = *(const uint2*)(G + o);
        uint2 ov;
        ov.x = pack2(O[d][4 * g + 0] * inv * bflo(gv.x), O[d][4 * g + 1] * inv * bfhi(gv.x));
        ov.y = pack2(O[d][4 * g + 2] * inv * bflo(gv.y), O[d][4 * g + 3] * inv * bfhi(gv.y));
        st8_wt(AO + o, ov);
      }
  }
}

DI void attn1_phase(const Params& p, unsigned char* smem, int cidx) {
  const int tid = threadIdx.x, lane = tid & 63, wave = tid >> 6;
  int* cnt = (int*)(p.ws + OFF_CNT) + cidx;
  int* s_item = (int*)(smem + 65536);
  const u16* Q = (const u16*)(p.ws + OFF_Q);
  const u16* G = (const u16*)(p.ws + OFF_G);
  u16* AO = (u16*)(p.ws + OFF_AO);
  float* xch = (float*)smem;
  float lam;
  {
    const float a = p.in[I_LQ1][lane] * p.in[I_LK1][lane];
    const float b = p.in[I_LQ2][lane] * p.in[I_LK2][lane];
    lam = __expf(wave_sum(a)) - __expf(wave_sum(b)) + LAM_INIT;
  }
  const int map = wave & 1, qsub = wave >> 1;
  for (int round = 0;; ++round) {
    if (tid == 0) *s_item = round == 0 ? (int)blockIdx.x : (int)gridDim.x + atomicAdd(cnt, 1);
    __syncthreads();
    const int item = *s_item;
    __syncthreads();
    if (item >= 768) break;
    int row0, head, vs, te1;
    const u16 *Kp, *Vp;
    if (item < 256) {
      const int b = item >> 7, hd = (item >> 4) & 7, qb = item & 15;
      head = hd;
      row0 = M_CTX + b * 1024 + qb * 64 + qsub * 32;
      Kp = (const u16*)(p.ws + OFF_KSC) + (size_t)(b * 16 + hd * 2) * 1280 * 64;
      Vp = (const u16*)(p.ws + OFF_VSC) + (size_t)(b * 8 + hd) * 128 * 1280;
      vs = 1280; te1 = 40;
    } else {
      const int r = item - 256, b = r >> 5, hd = (r >> 2) & 7, qb = r & 3;
      head = hd;
      row0 = b * 256 + qb * 64 + qsub * 32;
      Kp = (const u16*)(p.ws + OFF_KCC) + (size_t)(b * 16 + hd * 2) * 256 * 64;
      Vp = (const u16*)(p.ws + OFF_VCC) + (size_t)(b * 8 + hd) * 128 * 256;
      vs = 256; te1 = 8;
    }
    f32x16 O[4];
    float l;
    flash_lds<1>(Q + (size_t)row0 * 1024 + (head * 2 + map) * 64, smem, Kp, Kp + (size_t)vs * 64, Vp, vs, map,
                 0, te1, 0, 0, false, 0, -1e30f, 0.0f, O, l);
    const float inv = 1.0f / l;
    __syncthreads();
    if (map == 1) {
#pragma unroll
      for (int d = 0; d < 4; ++d)
#pragma unroll
        for (int i = 0; i < 16; ++i) xch[(qsub * 64 + d * 16 + i) * 64 + lane] = O[d][i] * inv;
    }
    __syncthreads();
    if (map == 0) {
      float ss = 0.f;
#pragma unroll
      for (int d = 0; d < 4; ++d)
#pragma unroll
        for (int i = 0; i < 16; ++i) {
          const float o = O[d][i] * inv - lam * xch[(qsub * 64 + d * 16 + i) * 64 + lane];
          O[d][i] = o;
          ss += o * o;
        }
      ss += __shfl_xor(ss, 32);
      const float rr = rsqrtf(ss * (1.0f / 128.0f) + EPS) * (1.0f - LAM_INIT);
      const int row = row0 + (lane & 31), h = lane >> 5;
      const float* sw = p.in[I_SUBLN];
#pragma unroll
      for (int d = 0; d < 4; ++d)
#pragma unroll
        for (int g = 0; g < 4; ++g) {
          const int dv = d * 32 + 8 * g + 4 * h;
          const size_t o = (size_t)row * 1024 + head * 128 + dv;
          const uint2 gv = *(const uint2*)(G + o);
          const float4 w4 = *(const float4*)(sw + dv);
          uint2 ov;
          ov.x = pack2(O[d][4 * g + 0] * rr * w4.x * bflo(gv.x), O[d][4 * g + 1] * rr * w4.y * bfhi(gv.x));
          ov.y = pack2(O[d][4 * g + 2] * rr * w4.z * bflo(gv.y), O[d][4 * g + 3] * rr * w4.w * bfhi(gv.y));
          st8_wt(AO + o, ov);
        }
    }
  }
}

DI unsigned bar_ld(unsigned* p) { return __hip_atomic_load(p, __ATOMIC_RELAXED, __HIP_MEMORY_SCOPE_AGENT); }
DI unsigned bar_add(unsigned* p, unsigned v) { return __hip_atomic_fetch_add(p, v, __ATOMIC_RELAXED, __HIP_MEMORY_SCOPE_AGENT); }
DI void grid_bar(unsigned* bar, unsigned& epoch) {
  asm volatile("s_waitcnt vmcnt(0)" ::: "memory");
  __syncthreads();
  if (threadIdx.x == 0) {
    epoch += 1;
    __builtin_amdgcn_fence(__ATOMIC_RELEASE, "agent");
    asm volatile("s_waitcnt vmcnt(0)" ::: "memory");
    const unsigned ng = gridDim.x < 8 ? gridDim.x : 8;
    const unsigned grp = blockIdx.x % ng;
    const unsigned nloc = (gridDim.x - grp + ng - 1) / ng;
    const unsigned old = bar_add(&bar[64 * (1 + grp)], 1u);
    if (old + 1u == epoch * nloc) {
      const unsigned o2 = bar_add(&bar[0], 1u);
      if (o2 + 1u == epoch * ng) __hip_atomic_store(&bar[64 * 9], epoch, __ATOMIC_RELAXED, __HIP_MEMORY_SCOPE_AGENT);
    }
    while (bar_ld(&bar[64 * 9]) < epoch) __builtin_amdgcn_s_sleep(1);
    __builtin_amdgcn_fence(__ATOMIC_ACQUIRE, "agent");
    asm volatile("s_waitcnt vmcnt(0)" ::: "memory");
  }
  __syncthreads();
}

#define XB_TMO      128
#define XB_XCNT(j)  (256  + 64 * (j))
#define XB_XSUB(j)  (1280 + 64 * (j))
#define XB_XGEN(j)  (2304 + 64 * (j))
#define XB_TOP      3328
#define XB_TOPGEN   3392
#define XCD_BAR_WORDS 3456
#define XB_SPIN_CAP (1u << 18)
#define LAS __attribute__((address_space(3)))

__device__ __forceinline__ unsigned xb_ld(unsigned* p)              { return __hip_atomic_load(p, __ATOMIC_RELAXED, __HIP_MEMORY_SCOPE_AGENT); }
__device__ __forceinline__ unsigned xb_add(unsigned* p, unsigned v) { return __hip_atomic_fetch_add(p, v, __ATOMIC_RELAXED, __HIP_MEMORY_SCOPE_AGENT); }
__device__ __forceinline__ unsigned xb_xcc_id() { return (unsigned)__builtin_amdgcn_s_getreg((3 << 11) | 20) & 0xFu; }
#define XB_SPIN(cond, bar) do { unsigned _sp = 0; while (cond) { __builtin_amdgcn_s_sleep(1); \
    if ((++_sp & 255u) == 0u) { if (xb_ld(&(bar)[XB_TMO])) break; if (_sp > XB_SPIN_CAP) { atomicAdd(&(bar)[XB_TMO], 1u); break; } } } } while (0)

struct XcdBarrier {
    unsigned* bar; unsigned x;
    volatile LAS unsigned* st;
};

__device__ __forceinline__ XcdBarrier xcd_barrier_post(unsigned* bar, volatile LAS unsigned* st) {
    XcdBarrier b; b.bar = bar; b.x = xb_xcc_id(); b.st = st;
    if (threadIdx.x == 0) (void)xb_add(&bar[XB_XCNT(b.x)], 1u);
    return b;
}
__device__ __forceinline__ void xcd_barrier_complete(unsigned* bar, unsigned x, unsigned& nloc, unsigned& nx) {
    const unsigned G = gridDim.x * gridDim.y * gridDim.z;
    unsigned sum, cnt, mine, sp = 0u;
    for (;;) {
        sum = 0u; cnt = 0u; mine = 0u;
#pragma unroll
        for (unsigned j = 0; j < 16; ++j) { const unsigned c = xb_ld(&bar[XB_XCNT(j)]); sum += c; cnt += (c > 0u) ? 1u : 0u; mine = (j == x) ? c : mine; }
        if (sum == G) break;
        __builtin_amdgcn_s_sleep(1);
        if ((++sp & 255u) == 0u) { if (xb_ld(&bar[XB_TMO])) break; if (sp > XB_SPIN_CAP) { atomicAdd(&bar[XB_TMO], 1u); break; } }
    }
    nloc = mine > 0u ? mine : 1u; nx = cnt > 0u ? cnt : 1u;
}

__device__ __forceinline__ void xcd_barrier(const XcdBarrier& b) {
    asm volatile("s_waitcnt vmcnt(0)" ::: "memory");
    __syncthreads();
    if (threadIdx.x == 0) {
        unsigned* bar = b.bar;
        __builtin_amdgcn_s_waitcnt(0);
        unsigned nloc = b.st[0], nx = b.st[1];
        if (nloc == 0u) { xcd_barrier_complete(bar, b.x, nloc, nx); b.st[0] = nloc; b.st[1] = nx; }
        const unsigned old = xb_add(&bar[XB_XSUB(b.x)], 1u);
        const unsigned gen = old / nloc;
        if (old + 1u == (gen + 1u) * nloc) {
            __builtin_amdgcn_fence(__ATOMIC_RELEASE, "agent");
            asm volatile("s_waitcnt vmcnt(0)" ::: "memory");
            const unsigned og = xb_add(&bar[XB_TOP], 1u);
            const unsigned tg = og / nx;
            if (og + 1u == (tg + 1u) * nx) xb_add(&bar[XB_TOPGEN], 1u);
            else XB_SPIN(xb_ld(&bar[XB_TOPGEN]) == tg, bar);
            __builtin_amdgcn_fence(__ATOMIC_ACQUIRE, "agent");
            xb_add(&bar[XB_XGEN(b.x)], 1u);
            asm volatile("s_waitcnt vmcnt(0)" ::: "memory");
        } else {
            XB_SPIN(xb_ld(&bar[XB_XGEN(b.x)]) == gen, bar);
            __builtin_amdgcn_fence(__ATOMIC_ACQUIRE, "agent");
            asm volatile("s_waitcnt vmcnt(0)" ::: "memory");
        }
    }
    __syncthreads();
}

__global__ void __launch_bounds__(256, 2) mega(Params p) {
  extern __shared__ __attribute__((aligned(16))) unsigned char smem[];
  cg::grid_group grid = cg::this_grid();
  unsigned* bar = (unsigned*)(p.ws + OFF_BAR);
  unsigned epoch = 0; (void)epoch;
  volatile LAS unsigned* xb_st = (volatile LAS unsigned*)(smem + 65536 + 16);
  if (threadIdx.x == 0) { xb_st[0] = 0u; xb_st[1] = 0u; }
  __syncthreads();
  XcdBarrier xb = xcd_barrier_post(bar, xb_st);
#define grid_bar(b_, e_) xcd_barrier(xb)
  if (p.ph_hi > 1000) grid.sync();
  int cidx = 0;
#define PHASE(k, call) if (p.ph_lo <= (k) && (k) < p.ph_hi) { { const bool EPI_ON = true; (void)EPI_ON; call; } if ((REP_MASK >> (k)) & 1) { const bool EPI_ON = (REP_EPI != 0); (void)EPI_ON; grid_bar(bar, epoch); call; } if ((k) + 1 < p.ph_hi) grid_bar(bar, epoch); }
  const bool fuse_ln = (p.ph_hi - p.ph_lo == 10) && (((gridDim.x & 7) == 0) ? ((gridDim.x >> 3) >= 48) : (gridDim.x >= 384));
  const bool fuse_h0 = (p.ph_hi - p.ph_lo == 10);
  PHASE(0, phase0(p, smem, fuse_h0))
  if (!fuse_h0) { PHASE(1, phase_h0(p)) }
  PHASE(2, gemm_phase<EPI_IN0>(p, smem, (const u16*)(p.ws + OFF_H), (const u16*)(p.ws + OFF_WIN0), 2560, EPI_ON))
  PHASE(3, attn0_phase(p, smem, cidx++))
  PHASE(4, gemm_phase<EPI_OUT0>(p, smem, (const u16*)(p.ws + OFF_AO), (const u16*)(p.ws + OFF_WOUT0), 1024, EPI_ON, fuse_ln))
  if (!fuse_ln) { PHASE(5, phase_ln<false>(p)) }
  PHASE(6, gemm_phase<EPI_IN1>(p, smem, (const u16*)(p.ws + OFF_H), (const u16*)(p.ws + OFF_WIN1), 4096, EPI_ON))
  PHASE(7, attn1_phase(p, smem, cidx++))
  if (fuse_ln) {
    if (p.ph_lo <= 8 && 8 < p.ph_hi) gemm_phase<EPI_OUT1>(p, smem, (const u16*)(p.ws + OFF_AO), (const u16*)(p.ws + OFF_WOUT1), 1024, true, true);
  } else {
    PHASE(8, gemm_phase<EPI_OUT1>(p, smem, (const u16*)(p.ws + OFF_AO), (const u16*)(p.ws + OFF_WOUT1), 1024, EPI_ON, false))
    PHASE(9, phase_ln<true>(p))
  }
}

extern "C" void kernel_launch(void* const* d_in, const int* in_sizes, int n_in, void* d_out, int out_size, void* d_ws,
                              size_t ws_size, hipStream_t stream) {
  static int grid_blocks = 0;
  if (!grid_blocks) {
    int dev = 0, cus = 0, per_cu = 0;
    (void)hipGetDevice(&dev);
    (void)hipDeviceGetAttribute(&cus, hipDeviceAttributeMultiprocessorCount, dev);
    if (hipFuncSetAttribute((const void*)mega, hipFuncAttributeMaxDynamicSharedMemorySize, LDS_BYTES) != hipSuccess)
      fprintf(stderr, "kernel_launch: hipFuncSetAttribute failed\n");
    if (hipOccupancyMaxActiveBlocksPerMultiprocessor(&per_cu, (const void*)mega, 256, LDS_BYTES) != hipSuccess || per_cu < 1) {
      fprintf(stderr, "kernel_launch: occupancy query gave %d\n", per_cu);
      per_cu = 1;
    }
    (void)hipGetLastError();
    if (per_cu > 2) per_cu = 2;
    if (cus <= 0) cus = 256;
    grid_blocks = cus * per_cu;
    if (ws_size < WS_END) fprintf(stderr, "kernel_launch: workspace too small\n");
  }
  (void)hipMemsetAsync((unsigned char*)d_ws + OFF_BAR, 0, BAR_BYTES, stream);
  Params p{};
  for (int i = 0; i < 26; ++i) p.in[i] = (const float*)d_in[i];
  p.out = (float*)d_out;
  p.ws = (unsigned char*)d_ws;
#if N_LAUNCH_MULTI
  for (int ph = 0; ph < 10; ++ph) {
    p.ph_lo = ph; p.ph_hi = ph + 1;
    hipLaunchKernelGGL(mega, dim3(grid_blocks), dim3(256), LDS_BYTES, stream, p);
  }
#else
  p.ph_lo = 0; p.ph_hi = 10;
  void* args[] = {&p};
  hipError_t e = hipLaunchCooperativeKernel((void*)mega, dim3(grid_blocks), dim3(256), args, LDS_BYTES, stream);
  if (e != hipSuccess) fprintf(stderr, "cooperative launch failed: %s (grid %d)\n", hipGetErrorString(e), grid_blocks);
#endif
}
```

```cpp
#include <hip/hip_runtime.h>
#include <hip/hip_cooperative_groups.h>
#include <cstdio>
namespace cg = cooperative_groups;

#ifndef GEMM_SKEW
#define GEMM_SKEW 0
#endif
#ifndef REP_EPI
#define REP_EPI 1
#endif
#ifndef REP_MASK
#define REP_MASK 0
#endif
#ifndef N_LAUNCH_MULTI
#define N_LAUNCH_MULTI 0
#endif

#define DI __device__ __forceinline__
typedef unsigned short u16;
using bf16x8 = __attribute__((ext_vector_type(8))) short;
using f32x4 = __attribute__((ext_vector_type(4))) float;
using f32x16 = __attribute__((ext_vector_type(16))) float;
typedef __bf16 bf2_t __attribute__((ext_vector_type(2)));
typedef float f2_t __attribute__((ext_vector_type(2)));

#define MFMA16(a, b, c) __builtin_amdgcn_mfma_f32_16x16x32_bf16((a), (b), (c), 0, 0, 0)
#define MFMA32(a, b, c) __builtin_amdgcn_mfma_f32_32x32x16_bf16((a), (b), (c), 0, 0, 0)

constexpr int M_CTX = 4096, M_ALL = 6144;
constexpr float ALPHA = 1.4142135623730951f;
constexpr float EPS = 1e-6f;
constexpr float LOG2E = 1.4426950408889634f;
constexpr float QSCALE = 0.125f * LOG2E;
constexpr float LAM_INIT = 0.35550906759096926f;

enum { I_XP = 0, I_XS, I_CAK, I_CAV, I_CBK, I_CBV, I_CCK, I_CCV, I_C, I_CCTX, I_WMOD, I_BMOD, I_LNG, I_LNB,
       I_WINE, I_WOUTE, I_QNA, I_KNA, I_SINK, I_WINO, I_WOUTO, I_LQ1, I_LK1, I_LQ2, I_LK2, I_SUBLN };

constexpr size_t O_YP = 0, O_YS = 4194304, O_AK = 6291456, O_AV = 6815744, O_BK = 7340032, O_BV = 7864320,
                 O_CK = 8388608, O_CV = 12582912;

constexpr size_t OFF_MOD = 0;
constexpr size_t OFF_ROPE = OFF_MOD + 73728;
constexpr size_t OFF_CNT = OFF_ROPE + 262144;
constexpr size_t OFF_WIN0 = OFF_CNT + 256;
constexpr size_t OFF_WOUT0 = OFF_WIN0 + 5242880;
constexpr size_t OFF_WIN1 = OFF_WOUT0 + 2097152;
constexpr size_t OFF_WOUT1 = OFF_WIN1 + 8388608;
constexpr size_t OFF_H = OFF_WOUT1 + 2097152;
constexpr size_t OFF_Q = OFF_H + 12582912;
constexpr size_t OFF_G = OFF_Q + 12582912;
constexpr size_t OFF_AO = OFF_G + 12582912;
constexpr size_t OFF_KCA = OFF_AO + 12582912;
constexpr size_t OFF_VCA = OFF_KCA + 1048576;
constexpr size_t OFF_KCB = OFF_VCA + 1048576;
constexpr size_t OFF_VCB = OFF_KCB + 1048576;
constexpr size_t OFF_KSA = OFF_VCB + 1048576;
constexpr size_t OFF_VSA = OFF_KSA + 655360;
constexpr size_t OFF_KSB = OFF_VSA + 655360;
constexpr size_t OFF_VSB = OFF_KSB + 655360;
constexpr size_t OFF_KCC = OFF_VSB + 655360;
constexpr size_t OFF_VCC = OFF_KCC + 8388608;
constexpr size_t OFF_KSC = OFF_VCC + 8388608;
constexpr size_t OFF_VSC = OFF_KSC + 5242880;
constexpr size_t OFF_R = OFF_VSC + 5242880;
constexpr size_t OFF_X1 = OFF_R + 25165824;
constexpr size_t OFF_BAR = OFF_X1 + 25165824;
constexpr size_t BAR_BYTES = 16384;
constexpr size_t OFF_PART = OFF_BAR + BAR_BYTES;
constexpr size_t WS_END = OFF_PART + 786432;
constexpr int BANDCNT_WORD = 3500;

constexpr int LDS_BYTES = 2 * 2 * 128 * 64 * 2 + 64;

struct Params {
  const float* in[26];
  float* out;
  unsigned char* ws;
  int ph_lo, ph_hi;
};

DI unsigned pack2(float a, float b) {
  f2_t v = {a, b};
  bf2_t r = __builtin_convertvector(v, bf2_t);
  return __builtin_bit_cast(unsigned, r);
}
DI u16 f2bf(float x) { return (u16)(pack2(x, 0.f) & 0xffffu); }
DI float bflo(unsigned u) { return __uint_as_float(u << 16); }
DI float bfhi(unsigned u) { return __uint_as_float(u & 0xffff0000u); }
DI float exp2f_fast(float x) { return __builtin_amdgcn_exp2f(x); }
DI float silu(float x) { return x * __builtin_amdgcn_rcpf(1.0f + __expf(-x)); }
typedef unsigned u32x4_t __attribute__((ext_vector_type(4)));
DI void st16_wt_raw(void* p, u32x4_t v) {
  asm volatile("global_store_dwordx4 %0, %1, off sc1\n\ts_nop 1" :: "v"(p), "v"(v) : "memory");
}
DI void st16_wt(void* p, uint4 v) { st16_wt_raw(p, u32x4_t{v.x, v.y, v.z, v.w}); }
DI void st16_wt(void* p, float4 v) {
  st16_wt_raw(p, u32x4_t{__float_as_uint(v.x), __float_as_uint(v.y), __float_as_uint(v.z), __float_as_uint(v.w)});
}
DI void st8_wt(void* p, uint2 v) {
  __hip_atomic_store((unsigned long long*)p, ((unsigned long long)v.y << 32) | v.x, __ATOMIC_RELAXED, __HIP_MEMORY_SCOPE_AGENT);
}
DI float wave_sum(float v) {
  v += __shfl_xor(v, 32); v += __shfl_xor(v, 16); v += __shfl_xor(v, 8);
  v += __shfl_xor(v, 4); v += __shfl_xor(v, 2); v += __shfl_xor(v, 1);
  return v;
}
DI float sum16(float v) {
  v += __shfl_xor(v, 8); v += __shfl_xor(v, 4); v += __shfl_xor(v, 2); v += __shfl_xor(v, 1);
  return v;
}
DI const float* xrow(const Params& p, int row) {
  return row < M_CTX ? p.in[I_XP] + (size_t)row * 1024 : p.in[I_XS] + (size_t)(row - M_CTX) * 1024;
}
DI int modvec(int row) { return row < M_CTX ? 0 : 1 + ((row - M_CTX) >> 10); }

DI void prep_item(const Params& p, unsigned char* smem, int item, int tid) {
  float* fs = (float*)smem;
  {
    if (item < 192) {
      const int l = item / 96, n0 = (item % 96) * 32;
      const int cq = tid & 7, kg = tid >> 3;
      const float* W = p.in[I_WMOD] + (size_t)l * 1024 * 3072 + n0 + cq * 4;
      const float* cc = p.in[I_CCTX];
      const float* c1 = p.in[I_C];
      float a0[4] = {0, 0, 0, 0}, a1[4] = {0, 0, 0, 0}, a2[4] = {0, 0, 0, 0};
      float* sl = fs + 4096;
#pragma unroll
      for (int j = 0; j < 12; ++j) {
        const int idx = tid + 256 * j, v = idx >> 10, k = idx & 1023;
        sl[idx] = silu(v == 0 ? cc[k] : c1[(v - 1) * 1024 + k]);
      }
      __syncthreads();
#pragma unroll 16
      for (int i = 0; i < 32; ++i) {
        const int k = kg * 32 + i;
        const f32x4 wv_ = __builtin_nontemporal_load((const f32x4*)(W + (size_t)k * 3072)); const float4 w = {wv_[0], wv_[1], wv_[2], wv_[3]};
        const float s0 = sl[k], s1 = sl[1024 + k], s2 = sl[2048 + k];
        a0[0] += s0 * w.x; a0[1] += s0 * w.y; a0[2] += s0 * w.z; a0[3] += s0 * w.w;
        a1[0] += s1 * w.x; a1[1] += s1 * w.y; a1[2] += s1 * w.z; a1[3] += s1 * w.w;
        a2[0] += s2 * w.x; a2[1] += s2 * w.y; a2[2] += s2 * w.z; a2[3] += s2 * w.w;
      }
#pragma unroll
      for (int e = 0; e < 4; ++e) {
        fs[kg * 96 + 0 + cq * 4 + e] = a0[e];
        fs[kg * 96 + 32 + cq * 4 + e] = a1[e];
        fs[kg * 96 + 64 + cq * 4 + e] = a2[e];
      }
      __syncthreads();
      if (tid < 96) {
        float s = 0;
        for (int g = 0; g < 32; ++g) s += fs[g * 96 + tid];
        const int v = tid >> 5, col = n0 + (tid & 31);
        s += p.in[I_BMOD][l * 3072 + col];
        ((float*)(p.ws + OFF_MOD))[(l * 3 + v) * 3072 + col] = s;
      }
      __syncthreads();
    } else {
      int t = item - 192;
      const float* W; u16* Wt; int N;
      if (t < 640) { W = p.in[I_WINE]; Wt = (u16*)(p.ws + OFF_WIN0); N = 2560; }
      else if (t < 896) { t -= 640; W = p.in[I_WOUTE]; Wt = (u16*)(p.ws + OFF_WOUT0); N = 1024; }
      else if (t < 1920) { t -= 896; W = p.in[I_WINO]; Wt = (u16*)(p.ws + OFF_WIN1); N = 4096; }
      else { t -= 1920; W = p.in[I_WOUTO]; Wt = (u16*)(p.ws + OFF_WOUT1); N = 1024; }
      const int nt = N / 64;
      const int k0 = (t / nt) * 64, n0 = (t % nt) * 64;
#pragma unroll
      for (int i = 0; i < 4; ++i) {
        const int idx = tid + 256 * i;
        const int row = idx >> 4, c4 = idx & 15;
        const f32x4 wv_ = __builtin_nontemporal_load((const f32x4*)(W + (size_t)(k0 + row) * N + n0 + c4 * 4)); const float4 w = {wv_[0], wv_[1], wv_[2], wv_[3]};
        fs[row * 65 + c4 * 4 + 0] = w.x; fs[row * 65 + c4 * 4 + 1] = w.y;
        fs[row * 65 + c4 * 4 + 2] = w.z; fs[row * 65 + c4 * 4 + 3] = w.w;
      }
      __syncthreads();
#pragma unroll
      for (int i = 0; i < 2; ++i) {
        const int idx = tid + 256 * i;
        const int n = idx >> 3, kc = idx & 7;
        uint4 o;
        o.x = pack2(fs[(kc * 8 + 0) * 65 + n], fs[(kc * 8 + 1) * 65 + n]);
        o.y = pack2(fs[(kc * 8 + 2) * 65 + n], fs[(kc * 8 + 3) * 65 + n]);
        o.z = pack2(fs[(kc * 8 + 4) * 65 + n], fs[(kc * 8 + 5) * 65 + n]);
        o.w = pack2(fs[(kc * 8 + 6) * 65 + n], fs[(kc * 8 + 7) * 65 + n]);
        st16_wt(Wt + (size_t)(n0 + n) * 1024 + k0 + kc * 8, o);
      }
      __syncthreads();
    }
  }
}
DI void phase0(const Params& p, unsigned char* smem) {
  const int tid = threadIdx.x;
  const int b = blockIdx.x, nb = gridDim.x;
  for (int item = b; item < 192; item += nb) prep_item(p, smem, item, tid);
  if (nb >= 384) {
    if (b < 192) { prep_item(p, smem, 192 + b, tid); prep_item(p, smem, 192 + 192 + b, tid); }
    else for (int t = 384 + (b - 192); t < 2176; t += nb - 192) prep_item(p, smem, 192 + t, tid);
  } else {
    for (int t = b; t < 2176; t += nb) prep_item(p, smem, 192 + t, tid);
  }
  const int gtid = blockIdx.x * 256 + tid, gsz = gridDim.x * 256;
  if (gtid < 64) ((int*)(p.ws + OFF_CNT))[gtid] = 0;
  float* tab = (float*)(p.ws + OFF_ROPE);
  for (int idx = gtid; idx < 1024 * 32; idx += gsz) {
    const int s = idx >> 5, i = idx & 31, which = i >> 4, fi = i & 15;
    const float pos = (float)(which ? (s & 63) : (s >> 6));
    const float freq = exp2f(-(float)fi * (13.287712379549449f / 16.0f));
    float tr = pos * freq * 0.15915494309189535f;
    tr = tr - floorf(tr);
    tab[s * 64 + which * 32 + fi] = __builtin_amdgcn_cosf(tr);
    tab[s * 64 + which * 32 + 16 + fi] = __builtin_amdgcn_sinf(tr);
  }
  for (int idx = gtid; idx < 2 * 256 * 128; idx += gsz) {
    const int b = idx >> 15, s = (idx >> 7) & 255, kvh = (idx >> 6) & 1, d = idx & 63;
    const size_t ko = ((size_t)(b * 2 + kvh) * 1280 + 1024 + s) * 64 + d;
    const size_t vo = ((size_t)(b * 2 + kvh) * 64 + d) * 1280 + 1024 + s;
    ((u16*)(p.ws + OFF_KSA))[ko] = f2bf(p.in[I_CAK][idx]);
    ((u16*)(p.ws + OFF_VSA))[vo] = f2bf(p.in[I_CAV][idx]);
    ((u16*)(p.ws + OFF_KSB))[ko] = f2bf(p.in[I_CBK][idx]);
    ((u16*)(p.ws + OFF_VSB))[vo] = f2bf(p.in[I_CBV][idx]);
  }
  for (int idx = gtid; idx < 2 * 256 * 1024; idx += gsz) {
    const int b = idx >> 18, s = (idx >> 10) & 255, col = idx & 1023;
    const int hh = col >> 6, d = col & 63, head = col >> 7, dv = col & 127;
    ((u16*)(p.ws + OFF_KSC))[((size_t)(b * 16 + hh) * 1280 + 1024 + s) * 64 + d] = f2bf(p.in[I_CCK][idx]);
    ((u16*)(p.ws + OFF_VSC))[((size_t)(b * 8 + head) * 128 + dv) * 1280 + 1024 + s] = f2bf(p.in[I_CCV][idx]);
  }
}

DI void phase_h0(const Params& p) {
  const int gtid = blockIdx.x * 256 + threadIdx.x, gsz = gridDim.x * 256;
  const float* mod = (const float*)(p.ws + OFF_MOD);
  u16* H = (u16*)(p.ws + OFF_H);
  for (int idx = gtid; idx < M_ALL * 128; idx += gsz) {
    const int row = idx >> 7, c = (idx & 127) * 8;
    const float* x = xrow(p, row) + c;
    const float* mv = mod + modvec(row) * 3072;
    const float4 x0 = *(const float4*)x, x1 = *(const float4*)(x + 4);
    const float4 sh0 = *(const float4*)(mv + c), sh1 = *(const float4*)(mv + c + 4);
    const float4 sc0 = *(const float4*)(mv + 1024 + c), sc1 = *(const float4*)(mv + 1024 + c + 4);
    uint4 o;
    o.x = pack2(x0.x * (1.f + sc0.x) + sh0.x, x0.y * (1.f + sc0.y) + sh0.y);
    o.y = pack2(x0.z * (1.f + sc0.z) + sh0.z, x0.w * (1.f + sc0.w) + sh0.w);
    o.z = pack2(x1.x * (1.f + sc1.x) + sh1.x, x1.y * (1.f + sc1.y) + sh1.y);
    o.w = pack2(x1.z * (1.f + sc1.z) + sh1.z, x1.w * (1.f + sc1.w) + sh1.w);
    st16_wt(H + (size_t)row * 1024 + c, o);
  }
}

template <bool FINAL>
DI void phase_ln(const Params& p) {
  const int lane = threadIdx.x & 63;
  const int gw = blockIdx.x * 4 + (threadIdx.x >> 6), nw = gridDim.x * 4;
  const int l = FINAL ? 1 : 0;
  const float* R = (const float*)(p.ws + OFF_R);
  const float* g = p.in[I_LNG] + l * 1024;
  const float* bb = p.in[I_LNB] + l * 1024;
  for (int row = gw; row < M_ALL; row += nw) {
    float4 v[4];
    float s = 0;
#pragma unroll
    for (int i = 0; i < 4; ++i) {
      v[i] = *(const float4*)(R + (size_t)row * 1024 + i * 256 + lane * 4);
      s += v[i].x + v[i].y + v[i].z + v[i].w;
    }
    const float mu = wave_sum(s) * (1.0f / 1024.0f);
    float q = 0;
#pragma unroll
    for (int i = 0; i < 4; ++i) {
      v[i].x -= mu; v[i].y -= mu; v[i].z -= mu; v[i].w -= mu;
      q += v[i].x * v[i].x + v[i].y * v[i].y + v[i].z * v[i].z + v[i].w * v[i].w;
    }
    const float rs = rsqrtf(wave_sum(q) * (1.0f / 1024.0f) + EPS);
#pragma unroll
    for (int i = 0; i < 4; ++i) {
      const int c = i * 256 + lane * 4;
      const float4 gg = *(const float4*)(g + c), be = *(const float4*)(bb + c);
      float4 y;
      y.x = v[i].x * rs * gg.x + be.x; y.y = v[i].y * rs * gg.y + be.y;
      y.z = v[i].z * rs * gg.z + be.z; y.w = v[i].w * rs * gg.w + be.w;
      if (FINAL) {
        st16_wt(p.out + (size_t)row * 1024 + c, y);
      } else {
        st16_wt((float*)(p.ws + OFF_X1) + (size_t)row * 1024 + c, y);
        const float* mv = (const float*)(p.ws + OFF_MOD) + (3 + modvec(row)) * 3072;
        const float4 sh = *(const float4*)(mv + c), sc = *(const float4*)(mv + 1024 + c);
        uint2 o;
        o.x = pack2(y.x * (1.f + sc.x) + sh.x, y.y * (1.f + sc.y) + sh.y);
        o.y = pack2(y.z * (1.f + sc.z) + sh.z, y.w * (1.f + sc.w) + sh.w);
        st8_wt((u16*)(p.ws + OFF_H) + (size_t)row * 1024 + c, o);
      }
    }
  }
}

DI void rope_T(const Params& p, f32x4 (&acc)[4][4], int rbase, int lane) {
  const float* tab = (const float*)(p.ws + OFF_ROPE);
  const int l15 = lane & 15, f0 = (lane >> 4) * 4;
#pragma unroll
  for (int mi = 0; mi < 4; ++mi) {
    const int s = (rbase + mi * 16 + l15 - M_CTX) & 1023;
    const float* t = tab + s * 64 + f0;
    const float4 cr = *(const float4*)(t), sr = *(const float4*)(t + 16), cc = *(const float4*)(t + 32), sc = *(const float4*)(t + 48);
    const float crv[4] = {cr.x, cr.y, cr.z, cr.w}, srv[4] = {sr.x, sr.y, sr.z, sr.w};
    const float ccv[4] = {cc.x, cc.y, cc.z, cc.w}, scv[4] = {sc.x, sc.y, sc.z, sc.w};
#pragma unroll
    for (int j = 0; j < 4; ++j) {
      const float x1 = acc[0][mi][j], x2 = acc[1][mi][j], y1 = acc[2][mi][j], y2 = acc[3][mi][j];
      acc[0][mi][j] = x1 * crv[j] - x2 * srv[j]; acc[1][mi][j] = x1 * srv[j] + x2 * crv[j];
      acc[2][mi][j] = y1 * ccv[j] - y2 * scv[j]; acc[3][mi][j] = y1 * scv[j] + y2 * ccv[j];
    }
  }
}
DI void rms_T(f32x4 (&acc)[4][4], const float* w, int lane) {
  const int f0 = (lane >> 4) * 4;
  float4 wv[4];
#pragma unroll
  for (int ni = 0; ni < 4; ++ni) wv[ni] = *(const float4*)(w + ni * 16 + f0);
#pragma unroll
  for (int mi = 0; mi < 4; ++mi) {
    float ss = 0;
#pragma unroll
    for (int ni = 0; ni < 4; ++ni)
#pragma unroll
      for (int j = 0; j < 4; ++j) ss += acc[ni][mi][j] * acc[ni][mi][j];
    ss += __shfl_xor(ss, 16);
    ss += __shfl_xor(ss, 32);
    const float r = rsqrtf(ss * (1.0f / 64.0f) + EPS);
#pragma unroll
    for (int ni = 0; ni < 4; ++ni) {
      acc[ni][mi][0] *= r * wv[ni].x; acc[ni][mi][1] *= r * wv[ni].y;
      acc[ni][mi][2] *= r * wv[ni].z; acc[ni][mi][3] *= r * wv[ni].w;
    }
  }
}
DI void store_bf16_T(f32x4 (&acc)[4][4], u16* dst, size_t ld, int lane, float scale) {
  const int l15 = lane & 15, f0 = (lane >> 4) * 4;
#pragma unroll
  for (int mi = 0; mi < 4; ++mi)
#pragma unroll
    for (int ni = 0; ni < 4; ++ni) {
      uint2 o;
      o.x = pack2(acc[ni][mi][0] * scale, acc[ni][mi][1] * scale);
      o.y = pack2(acc[ni][mi][2] * scale, acc[ni][mi][3] * scale);
      *(uint2*)(dst + (size_t)(mi * 16 + l15) * ld + ni * 16 + f0) = o;
    }
}
DI void store_f32_T(f32x4 (&acc)[4][4], float* dst, size_t ld, int lane) {
  const int l15 = lane & 15, f0 = (lane >> 4) * 4;
#pragma unroll
  for (int mi = 0; mi < 4; ++mi)
#pragma unroll
    for (int ni = 0; ni < 4; ++ni) {
      float4 o = {acc[ni][mi][0], acc[ni][mi][1], acc[ni][mi][2], acc[ni][mi][3]};
      *(float4*)(dst + (size_t)(mi * 16 + l15) * ld + ni * 16 + f0) = o;
    }
}
DI void silu_tile(f32x4 (&acc)[4][4]) {
#pragma unroll
  for (int a = 0; a < 4; ++a)
#pragma unroll
    for (int b = 0; b < 4; ++b)
#pragma unroll
      for (int j = 0; j < 4; ++j) acc[a][b][j] = silu(acc[a][b][j]);
}
DI void stage_bf16_T(f32x4 (&acc)[4][4], unsigned char* stg, u16* dst, size_t ld, int lane, float scale) {
  const int l15 = lane & 15, g = lane >> 4;
#pragma unroll
  for (int mi = 0; mi < 4; ++mi)
#pragma unroll
    for (int ni = 0; ni < 4; ++ni) {
      uint2 o;
      o.x = pack2(acc[ni][mi][0] * scale, acc[ni][mi][1] * scale);
      o.y = pack2(acc[ni][mi][2] * scale, acc[ni][mi][3] * scale);
      *(uint2*)(stg + (mi * 16 + l15) * 144 + ni * 32 + g * 8) = o;
    }
#pragma unroll
  for (int i = 0; i < 8; ++i) {
    const int id = lane + 64 * i, row = id >> 3, c = id & 7;
    const uint4 v = *(const uint4*)(stg + row * 144 + c * 16);
    st16_wt(dst + (size_t)row * ld + c * 8, v);
  }
}
DI void stage_f32_half_T(f32x4 (&acc)[4][4], unsigned char* stg, int half, int lane) {
  const int l15 = lane & 15, g = lane >> 4;
#pragma unroll
  for (int m2 = 0; m2 < 2; ++m2)
#pragma unroll
    for (int ni = 0; ni < 4; ++ni) {
      const int mi = half * 2 + m2;
      float4 o = {acc[ni][mi][0], acc[ni][mi][1], acc[ni][mi][2], acc[ni][mi][3]};
      *(float4*)(stg + (m2 * 16 + l15) * 272 + (ni * 16 + g * 4) * 4) = o;
    }
}
DI void stage_f32_T(f32x4 (&acc)[4][4], unsigned char* stg, float* dst, size_t ld, int lane) {
#pragma unroll
  for (int half = 0; half < 2; ++half) {
    stage_f32_half_T(acc, stg, half, lane);
#pragma unroll
    for (int i = 0; i < 8; ++i) {
      const int id = lane + 64 * i, row = id >> 4, c = id & 15;
      const float4 v = *(const float4*)(stg + row * 272 + c * 16);
      st16_wt(dst + (size_t)(half * 32 + row) * ld + c * 4, v);
    }
  }
}
DI void store_f32_N(f32x4 (&acc)[4][4], float* dst, size_t ld, int lane) {
  const int c = lane & 15, rq = (lane >> 4) * 4;
#pragma unroll
  for (int mi = 0; mi < 4; ++mi)
#pragma unroll
    for (int j = 0; j < 4; ++j)
#pragma unroll
      for (int ni = 0; ni < 4; ++ni) dst[(size_t)(mi * 16 + rq + j) * ld + ni * 16 + c] = acc[mi][ni][j];
}
DI void store_tr_N(f32x4 (&acc)[4][4], u16* dst, size_t ld, int lane) {
  const int c = lane & 15, rq = (lane >> 4) * 4;
#pragma unroll
  for (int mi = 0; mi < 4; ++mi)
#pragma unroll
    for (int ni = 0; ni < 4; ++ni) {
      uint2 o;
      o.x = pack2(acc[mi][ni][0], acc[mi][ni][1]);
      o.y = pack2(acc[mi][ni][2], acc[mi][ni][3]);
      st8_wt(dst + (size_t)(ni * 16 + c) * ld + mi * 16 + rq, o);
    }
}
DI void store_k(const Params& p, f32x4 (&acc)[4][4], unsigned char* stg, int rbase, int lane, int nh, int hidx, size_t off_kc, size_t off_ks) {
  if (rbase < M_CTX) {
    const int b = rbase >> 8, s0 = rbase & 255;
    stage_bf16_T(acc, stg, (u16*)(p.ws + off_kc) + ((size_t)(b * nh + hidx) * 256 + s0) * 64, 64, lane, 1.0f);
  } else {
    const int r = rbase - M_CTX, b = r >> 10, s0 = r & 1023;
    stage_bf16_T(acc, stg, (u16*)(p.ws + off_ks) + ((size_t)(b * nh + hidx) * 1280 + s0) * 64, 64, lane, 1.0f);
  }
}
DI void store_v(const Params& p, f32x4 (&acc)[4][4], int rbase, int lane, int nh, int hidx, int dvh, int dv0, size_t off_vc, size_t off_vs) {
  if (rbase < M_CTX) {
    const int b = rbase >> 8, s0 = rbase & 255;
    store_tr_N(acc, (u16*)(p.ws + off_vc) + ((size_t)(b * nh + hidx) * dvh + dv0) * 256 + s0, 256, lane);
  } else {
    const int r = rbase - M_CTX, b = r >> 10, s0 = r & 1023;
    store_tr_N(acc, (u16*)(p.ws + off_vs) + ((size_t)(b * nh + hidx) * dvh + dv0) * 1280 + s0, 1280, lane);
  }
}

enum { EPI_IN0 = 0, EPI_OUT0 = 1, EPI_IN1 = 2, EPI_OUT1 = 3 };

template <int EPI>
DI bool is_v_tile(int n0) {
  if (EPI == EPI_IN0) return n0 == 640 || n0 == 1920;
  if (EPI == EPI_IN1) return n0 >= 2048 && n0 < 3072;
  return false;
}

template <int EPI>
DI void epilogue(const Params& p, f32x4 (&acc)[4][4], unsigned char* stg, int rbase, int cb, int lane) {
  const bool smp = rbase >= M_CTX;
  u16* Q = (u16*)(p.ws + OFF_Q);
  u16* G = (u16*)(p.ws + OFF_G);
  if (EPI == EPI_IN0) {
    if (cb < 512) {
      rms_T(acc, p.in[I_QNA], lane);
      if (smp) rope_T(p, acc, rbase, lane);
      stage_bf16_T(acc, stg, Q + (size_t)rbase * 1024 + cb, 1024, lane, QSCALE);
    } else if (cb < 640) {
      const int kvh = (cb - 512) >> 6;
      rms_T(acc, p.in[I_KNA], lane);
      if (!smp) stage_f32_T(acc, stg, p.out + O_AK + (size_t)rbase * 128 + kvh * 64, 128, lane);
      else rope_T(p, acc, rbase, lane);
      store_k(p, acc, stg, rbase, lane, 2, kvh, OFF_KCA, OFF_KSA);
    } else if (cb < 768) {
      const int kvh = (cb - 640) >> 6;
      if (!smp) store_f32_N(acc, p.out + O_AV + (size_t)rbase * 128 + kvh * 64, 128, lane);
      store_v(p, acc, rbase, lane, 2, kvh, 64, 0, OFF_VCA, OFF_VSA);
    } else if (cb < 1280) {
      silu_tile(acc);
      stage_bf16_T(acc, stg, G + (size_t)rbase * 1024 + (cb - 768), 1024, lane, 1.0f);
    } else if (cb < 1792) {
      if (smp) rope_T(p, acc, rbase, lane);
      stage_bf16_T(acc, stg, Q + (size_t)rbase * 1024 + 512 + (cb - 1280), 1024, lane, QSCALE);
    } else if (cb < 1920) {
      const int kvh = (cb - 1792) >> 6;
      if (!smp) stage_f32_T(acc, stg, p.out + O_BK + (size_t)rbase * 128 + kvh * 64, 128, lane);
      else rope_T(p, acc, rbase, lane);
      store_k(p, acc, stg, rbase, lane, 2, kvh, OFF_KCB, OFF_KSB);
    } else if (cb < 2048) {
      const int kvh = (cb - 1920) >> 6;
      if (!smp) store_f32_N(acc, p.out + O_BV + (size_t)rbase * 128 + kvh * 64, 128, lane);
      store_v(p, acc, rbase, lane, 2, kvh, 64, 0, OFF_VCB, OFF_VSB);
    } else {
      silu_tile(acc);
      stage_bf16_T(acc, stg, G + (size_t)rbase * 1024 + 512 + (cb - 2048), 1024, lane, 1.0f);
    }
  } else if (EPI == EPI_IN1) {
    if (cb < 1024) {
      if (smp) rope_T(p, acc, rbase, lane);
      stage_bf16_T(acc, stg, Q + (size_t)rbase * 1024 + cb, 1024, lane, QSCALE);
    } else if (cb < 2048) {
      const int hh = (cb - 1024) >> 6;
      if (!smp) stage_f32_T(acc, stg, p.out + O_CK + (size_t)rbase * 1024 + (cb - 1024), 1024, lane);
      else rope_T(p, acc, rbase, lane);
      store_k(p, acc, stg, rbase, lane, 16, hh, OFF_KCC, OFF_KSC);
    } else if (cb < 3072) {
      const int head = (cb - 2048) >> 7, dv0 = (cb - 2048) & 127;
      if (!smp) store_f32_N(acc, p.out + O_CV + (size_t)rbase * 1024 + (cb - 2048), 1024, lane);
      store_v(p, acc, rbase, lane, 8, head, 128, dv0, OFF_VCC, OFF_VSC);
    } else {
      silu_tile(acc);
      stage_bf16_T(acc, stg, G + (size_t)rbase * 1024 + (cb - 3072), 1024, lane, 1.0f);
    }
  } else {
    const int l = (EPI == EPI_OUT0) ? 0 : 1;
    const float* gate = (const float*)(p.ws + OFF_MOD) + (l * 3 + modvec(rbase)) * 3072 + 2048 + cb;
    const float* xres = ((EPI == EPI_OUT0) ? xrow(p, rbase) : (const float*)(p.ws + OFF_X1) + (size_t)rbase * 1024) + cb;
    float* R = (float*)(p.ws + OFF_R) + (size_t)rbase * 1024 + cb;
    const int c = lane & 15;
    const float4 gv = *(const float4*)(gate + c * 4);
#pragma unroll
    for (int half = 0; half < 2; ++half) {
      stage_f32_half_T(acc, stg, half, lane);
#pragma unroll
      for (int i = 0; i < 8; ++i) {
        const int row = (lane >> 4) + 4 * i;
        const float4 a = *(const float4*)(stg + row * 272 + c * 16);
        const size_t o = (size_t)(half * 32 + row) * 1024 + c * 4;
        const float4 x = *(const float4*)(xres + o);
        float4 r;
        r.x = ALPHA * x.x + gv.x * a.x; r.y = ALPHA * x.y + gv.y * a.y;
        r.z = ALPHA * x.z + gv.z * a.z; r.w = ALPHA * x.w + gv.w * a.w;
        st16_wt(R + o, r);
      }
    }
  }
}

DI void gemm_stage(const u16* ag, const u16* bg, u16* sa, u16* sb, int tid, int k0) {
#pragma unroll
  for (int i = 0; i < 4; ++i) {
    const int id = tid + 256 * i;
    const int row = id >> 3, c = (id & 7) ^ ((row >> 1) & 7);
    __builtin_amdgcn_global_load_lds((const unsigned*)(ag + (size_t)row * 1024 + k0 + c * 8), (unsigned*)(sa + id * 8), 16, 0, 0);
    __builtin_amdgcn_global_load_lds((const unsigned*)(bg + (size_t)row * 1024 + k0 + c * 8), (unsigned*)(sb + id * 8), 16, 0, 0);
  }
}

template <bool SWAP>
DI void gemm_mainloop(const u16* ag, const u16* bg, u16* sA, u16* sB, int tid, int wm, int wn, f32x4 (&acc)[4][4]) {
  const int lane = tid & 63;
#pragma unroll
  for (int a = 0; a < 4; ++a)
#pragma unroll
    for (int b = 0; b < 4; ++b) acc[a][b] = f32x4{0.f, 0.f, 0.f, 0.f};
  gemm_stage(ag, bg, sA, sB, tid, 0);
  __syncthreads();
  const int ra = wm * 64 + (lane & 15), rb = wn * 64 + (lane & 15);
  const int swa = (ra >> 1) & 7, swb = (rb >> 1) & 7;
  const int q = lane >> 4;
#pragma unroll 2
  for (int kt = 0; kt < 16; ++kt) {
    const int cur = kt & 1;
    if (kt + 1 < 16) gemm_stage(ag, bg, sA + (cur ^ 1) * 8192, sB + (cur ^ 1) * 8192, tid, (kt + 1) * 64);
    const u16* a_s = sA + cur * 8192 + ra * 64;
    const u16* b_s = sB + cur * 8192 + rb * 64;
#pragma unroll
    for (int ks = 0; ks < 2; ++ks) {
      bf16x8 af[4], bfr[4];
#pragma unroll
      for (int mi = 0; mi < 4; ++mi) af[mi] = *(const bf16x8*)(a_s + mi * 16 * 64 + (((ks * 4 + q) ^ swa) * 8));
#pragma unroll
      for (int ni = 0; ni < 4; ++ni) bfr[ni] = *(const bf16x8*)(b_s + ni * 16 * 64 + (((ks * 4 + q) ^ swb) * 8));
#pragma unroll
      for (int a = 0; a < 4; ++a)
#pragma unroll
        for (int b = 0; b < 4; ++b) {
          if (SWAP) acc[a][b] = MFMA16(bfr[a], af[b], acc[a][b]);
          else acc[a][b] = MFMA16(af[a], bfr[b], acc[a][b]);
        }
    }
    __syncthreads();
  }
}

template <int EPI>
DI void gemm_phase(const Params& p, unsigned char* smem, const u16* A, const u16* Wt, int N, bool do_epi = true, bool fuse_ln = false) {
  const int tid = threadIdx.x, lane = tid & 63, wave = tid >> 6;
  const int wm = wave >> 1, wn = wave & 1;
  const int NT = N >> 7;
  const int ntiles = 48 * NT;
  u16* sA = (u16*)smem;
  u16* sB = sA + 2 * 8192;
#if GEMM_SKEW
  if (blockIdx.x >= (gridDim.x >> 1)) { for (int i = 0; i < GEMM_SKEW; ++i) __builtin_amdgcn_s_sleep(127); }
#endif
  const bool xcd_map = (gridDim.x & 7) == 0;
  const int nslot = xcd_map ? (gridDim.x >> 3) : gridDim.x;
  const int slot = xcd_map ? (blockIdx.x >> 3) : blockIdx.x;
  const int nloc = xcd_map ? 6 * NT : ntiles;
  for (int j = slot; j < nloc; j += nslot) {
    int tm, tn;
    if (xcd_map) { tn = j / 6; tm = (blockIdx.x & 7) * 6 + (j - tn * 6); }
    else { tm = j / NT; tn = j - tm * NT; }
    const int m0 = tm * 128, n0 = tn * 128;
    f32x4 acc[4][4];
    const u16* ag = A + (size_t)m0 * 1024;
    const u16* bg = Wt + (size_t)n0 * 1024;
    if (is_v_tile<EPI>(n0)) gemm_mainloop<false>(ag, bg, sA, sB, tid, wm, wn, acc);
    else gemm_mainloop<true>(ag, bg, sA, sB, tid, wm, wn, acc);
    int lane_e = lane;
    asm volatile("" : "+v"(lane_e));
    if (do_epi && fuse_ln && (EPI == EPI_OUT0 || EPI == EPI_OUT1))
      epilogue_ln<(EPI == EPI_OUT1) ? EPI_OUT1 : EPI_OUT0>(p, acc, smem + wave * 9216, m0 + wm * 64, n0 + wn * 64, lane_e, tm, tn * 2 + wn);
    else if (do_epi) epilogue<EPI>(p, acc, smem + wave * 9216, m0 + wm * 64, n0 + wn * 64, lane_e);
    else if (p.ph_hi > 1000) {
      float s = 0;
      for (int a = 0; a < 4; ++a) for (int b = 0; b < 4; ++b) s += acc[a][b][0] + acc[a][b][1] + acc[a][b][2] + acc[a][b][3];
      p.out[lane_e] = s;
    }
    __syncthreads();
  }
}

DI unsigned band_ld(unsigned* p) { return __hip_atomic_load(p, __ATOMIC_RELAXED, __HIP_MEMORY_SCOPE_AGENT); }
template <int EPI>
DI void epilogue_ln(const Params& p, f32x4 (&acc)[4][4], unsigned char* stg, int rbase, int cb, int lane, int tm, int slot16) {
  constexpr int l = (EPI == EPI_OUT0) ? 0 : 1;
  const int l15 = lane & 15, g = lane >> 4, f0 = g * 4;
  const float* mod = (const float*)(p.ws + OFF_MOD);
  const int mv = modvec(rbase);
  {
    const float* gate = mod + (l * 3 + mv) * 3072 + 2048 + cb + f0;
    const float* xres = ((EPI == EPI_OUT0) ? xrow(p, rbase) : (const float*)(p.ws + OFF_X1) + (size_t)rbase * 1024) + cb + f0;
    float4 gv[4];
#pragma unroll
    for (int ni = 0; ni < 4; ++ni) gv[ni] = *(const float4*)(gate + ni * 16);
#pragma unroll
    for (int mi = 0; mi < 4; ++mi)
#pragma unroll
      for (int ni = 0; ni < 4; ++ni) {
        const float4 x = *(const float4*)(xres + (size_t)(mi * 16 + l15) * 1024 + ni * 16);
        acc[ni][mi][0] = ALPHA * x.x + gv[ni].x * acc[ni][mi][0]; acc[ni][mi][1] = ALPHA * x.y + gv[ni].y * acc[ni][mi][1];
        acc[ni][mi][2] = ALPHA * x.z + gv[ni].z * acc[ni][mi][2]; acc[ni][mi][3] = ALPHA * x.w + gv[ni].w * acc[ni][mi][3];
      }
  }
  unsigned long long* part = (unsigned long long*)(p.ws + OFF_PART);
#pragma unroll
  for (int mi = 0; mi < 4; ++mi) {
    float s = 0.f, q = 0.f;
#pragma unroll
    for (int ni = 0; ni < 4; ++ni)
#pragma unroll
      for (int j = 0; j < 4; ++j) { s += acc[ni][mi][j]; q += acc[ni][mi][j] * acc[ni][mi][j]; }
    s += __shfl_xor(s, 16); s += __shfl_xor(s, 32);
    q += __shfl_xor(q, 16); q += __shfl_xor(q, 32);
    if (g == 0) st8_wt(part + (size_t)(rbase + mi * 16 + l15) * 16 + slot16, uint2{__float_as_uint(s), __float_as_uint(q)});
  }
  asm volatile("s_waitcnt vmcnt(0)" ::: "memory");
  __syncthreads();
  if (threadIdx.x == 0) {
    unsigned* bc = (unsigned*)(p.ws + OFF_BAR) + BANDCNT_WORD + l * 48 + tm;
    __hip_atomic_fetch_add(bc, 1u, __ATOMIC_RELAXED, __HIP_MEMORY_SCOPE_AGENT);
    unsigned spins = 0;
    while (band_ld(bc) < 8u && ++spins < (1u << 22)) __builtin_amdgcn_s_sleep(1);
    __builtin_amdgcn_fence(__ATOMIC_ACQUIRE, "agent");
    asm volatile("s_waitcnt vmcnt(0)" ::: "memory");
  }
  __syncthreads();
  const float* lg = p.in[I_LNG] + l * 1024 + cb + f0;
  const float* lb = p.in[I_LNB] + l * 1024 + cb + f0;
  float4 gam[4], bet[4];
#pragma unroll
  for (int ni = 0; ni < 4; ++ni) { gam[ni] = *(const float4*)(lg + ni * 16); bet[ni] = *(const float4*)(lb + ni * 16); }
#pragma unroll
  for (int mi = 0; mi < 4; ++mi) {
    unsigned long long* pr = part + (size_t)(rbase + mi * 16 + l15) * 16 + g * 4;
    float s = 0.f, q = 0.f;
#pragma unroll
    for (int k = 0; k < 4; ++k) {
      const unsigned long long v = __hip_atomic_load(pr + k, __ATOMIC_RELAXED, __HIP_MEMORY_SCOPE_AGENT);
      s += __uint_as_float((unsigned)v); q += __uint_as_float((unsigned)(v >> 32));
    }
    s += __shfl_xor(s, 16); s += __shfl_xor(s, 32);
    q += __shfl_xor(q, 16); q += __shfl_xor(q, 32);
    const float mean = s * (1.0f / 1024.0f);
    const float var = fmaxf(q * (1.0f / 1024.0f) - mean * mean, 0.f);
    const float rstd = rsqrtf(var + EPS);
#pragma unroll
    for (int ni = 0; ni < 4; ++ni) {
      acc[ni][mi][0] = (acc[ni][mi][0] - mean) * rstd * gam[ni].x + bet[ni].x; acc[ni][mi][1] = (acc[ni][mi][1] - mean) * rstd * gam[ni].y + bet[ni].y;
      acc[ni][mi][2] = (acc[ni][mi][2] - mean) * rstd * gam[ni].z + bet[ni].z; acc[ni][mi][3] = (acc[ni][mi][3] - mean) * rstd * gam[ni].w + bet[ni].w;
    }
  }
  if (EPI == EPI_OUT0) {
    stage_f32_T(acc, stg, (float*)(p.ws + OFF_X1) + (size_t)rbase * 1024 + cb, 1024, lane);
    const float* m1 = mod + (3 + mv) * 3072 + cb + f0;
#pragma unroll
    for (int ni = 0; ni < 4; ++ni) {
      const float4 sh = *(const float4*)(m1 + ni * 16), sc = *(const float4*)(m1 + 1024 + ni * 16);
#pragma unroll
      for (int mi = 0; mi < 4; ++mi) {
        acc[ni][mi][0] = acc[ni][mi][0] * (1.f + sc.x) + sh.x; acc[ni][mi][1] = acc[ni][mi][1] * (1.f + sc.y) + sh.y;
        acc[ni][mi][2] = acc[ni][mi][2] * (1.f + sc.z) + sh.z; acc[ni][mi][3] = acc[ni][mi][3] * (1.f + sc.w) + sh.w;
      }
    }
    stage_bf16_T(acc, stg, (u16*)(p.ws + OFF_H) + (size_t)rbase * 1024 + cb, 1024, lane, 1.0f);
  } else {
    stage_f32_T(acc, stg, p.out + (size_t)rbase * 1024 + cb, 1024, lane);
  }
}

DI void glds16_asm(const void* gsrc, unsigned lds_dst) {
  unsigned keep;
  asm volatile("s_mov_b32 %0, m0\n\ts_mov_b32 m0, %2\n\ts_nop 0\n\tglobal_load_lds_dwordx4 %1, off\n\ts_mov_b32 m0, %0"
               : "=&s"(keep) : "v"(gsrc), "s"(lds_dst) : "memory");
}
template <int LAYER>
DI void attn_issue(unsigned st, const u16* Kg0, const u16* Kg1, const u16* Vg, int vs, int key0, int tid) {
  const unsigned wb = __builtin_amdgcn_readfirstlane(st + (unsigned)(tid >> 6) * 1024u);
  if (LAYER == 0) {
#pragma unroll
    for (int i = 0; i < 2; ++i) {
      const int id = tid + 256 * i, row = id >> 3, c = (id & 7) ^ ((row >> 1) & 7);
      glds16_asm(Kg0 + (size_t)(key0 + row) * 64 + c * 8, wb + i * 4096);
      glds16_asm(Vg + (size_t)row * vs + key0 + c * 8, wb + 8192 + i * 4096);
    }
  } else {
    {
      const int id = tid, row = id >> 3, c = (id & 7) ^ ((row >> 1) & 7);
      glds16_asm(Kg0 + (size_t)(key0 + row) * 64 + c * 8, wb);
      glds16_asm(Kg1 + (size_t)(key0 + row) * 64 + c * 8, wb + 4096);
    }
#pragma unroll
    for (int i = 0; i < 2; ++i) {
      const int id = tid + 256 * i, row = id >> 2, c = (id & 3) ^ ((row >> 2) & 3);
      glds16_asm(Vg + (size_t)row * vs + key0 + c * 8, wb + 8192 + i * 4096);
    }
  }
}

template <int LAYER>
DI void flash_lds(const u16* Qp, unsigned char* ring, const u16* Kg0, const u16* Kg1, const u16* Vg, int vs, int kmap,
                  int tb1, int te1, int tb2, int te2, bool use_mask, int qpos0, float m_init, float l_init,
                  f32x16 (&O)[LAYER ? 4 : 2], float& l_out) {
  constexpr int DV = LAYER ? 128 : 64;
  constexpr int NSUB = LAYER ? 1 : 2;
  constexpr int KS = 32 * NSUB;
  const int tid = threadIdx.x, lane = tid & 63, r = lane & 31, h = lane >> 5;
  bf16x8 qf[4];
#pragma unroll
  for (int ks = 0; ks < 4; ++ks) qf[ks] = *(const bf16x8*)(Qp + (size_t)r * 1024 + ks * 16 + 8 * h);
#pragma unroll
  for (int d = 0; d < DV / 32; ++d)
#pragma unroll
    for (int i = 0; i < 16; ++i) O[d][i] = 0.f;
  float m = m_init;
  const f32x16 zero16 = {0.f, 0.f, 0.f, 0.f, 0.f, 0.f, 0.f, 0.f, 0.f, 0.f, 0.f, 0.f, 0.f, 0.f, 0.f, 0.f};
  f32x16 L = zero16;
  L[0] = l_init;
  const short one_bf = (r == 0 || r == 4) ? (short)0x3F80 : (short)0;
  const bf16x8 onesf = {one_bf, one_bf, one_bf, one_bf, one_bf, one_bf, one_bf, one_bf};
  const int pr = (r & 0x13) | ((r & 4) << 1) | ((r & 8) >> 1);
  const int n1 = te1 - tb1, ntot = n1 + (te2 - tb2);
  const int koff = (LAYER ? kmap * 4096 : 0) + pr * 128;
  const int ksw = (pr >> 1) & 7;
  const int voff = 8192 + (LAYER ? r * 64 : r * 128);
  const int vsw = LAYER ? ((r >> 2) & 3) : ((r >> 1) & 7);
  asm volatile("" : "+v"(qf[0]), "+v"(qf[1]), "+v"(qf[2]), "+v"(qf[3]));
  asm volatile("s_waitcnt vmcnt(0)" ::: "memory");
#define TKEY(it_) (((it_) < n1 ? tb1 + (it_) : tb2 + ((it_) - n1)) * KS)
  const unsigned ring_lds = (unsigned)(size_t)ring;
  attn_issue<LAYER>(ring_lds, Kg0, Kg1, Vg, vs, TKEY(0), tid);
  if (ntot > 1) attn_issue<LAYER>(ring_lds + 16384, Kg0, Kg1, Vg, vs, TKEY(1), tid);
  if (ntot > 2) attn_issue<LAYER>(ring_lds + 32768, Kg0, Kg1, Vg, vs, TKEY(2), tid);
  for (int it = 0; it < ntot; ++it) {
    const int rem = ntot - 1 - it;
    if (rem >= 2) asm volatile("s_waitcnt vmcnt(8)" ::: "memory");
    else if (rem == 1) asm volatile("s_waitcnt vmcnt(4)" ::: "memory");
    else asm volatile("s_waitcnt vmcnt(0)" ::: "memory");
    __builtin_amdgcn_s_barrier();
    if (it + 3 < ntot) attn_issue<LAYER>(ring_lds + ((it + 3) & 3) * 16384, Kg0, Kg1, Vg, vs, TKEY(it + 3), tid);
    const unsigned char* st = ring + (it & 3) * 16384;
    const int key0 = TKEY(it);
    f32x16 S[NSUB];
#pragma unroll
    for (int u = 0; u < NSUB; ++u) {
      bf16x8 kf[4];
#pragma unroll
      for (int ks = 0; ks < 4; ++ks) kf[ks] = *(const bf16x8*)(st + koff + u * 4096 + (((ks * 2 + h) ^ ksw) * 16));
      S[u] = MFMA32(kf[0], qf[0], zero16);
#pragma unroll
      for (int ks = 1; ks < 4; ++ks) S[u] = MFMA32(kf[ks], qf[ks], S[u]);
    }
    if (use_mask && it < n1 && !(key0 >= qpos0 + 31 - 128 && key0 + KS - 1 <= qpos0 + 128)) {
      const int q = qpos0 + r;
#pragma unroll
      for (int u = 0; u < NSUB; ++u)
#pragma unroll
        for (int i = 0; i < 16; ++i) {
          const int key = key0 + 32 * u + (i & 3) + 4 * ((i >> 2) & 1) + 8 * h + 16 * (i >> 3);
          const int dlt = key - q;
          S[u][i] = (dlt <= 128 && dlt >= -128) ? S[u][i] : -1e30f;
        }
    }
    float mx = S[0][0];
#pragma unroll
    for (int u = 0; u < NSUB; ++u)
#pragma unroll
      for (int i = 0; i < 16; ++i) mx = fmaxf(mx, S[u][i]);
    {
      const unsigned mu = __float_as_uint(mx);
      const auto sw = __builtin_amdgcn_permlane32_swap(mu, mu, false, false);
      mx = fmaxf(__uint_as_float(sw[0]), __uint_as_float(sw[1]));
    }
    const float mn = fmaxf(m, mx);
    if (__builtin_amdgcn_ballot_w64(mn != m) != 0) {
      const float alpha = exp2f_fast(m - mn);
#pragma unroll
      for (int d = 0; d < DV / 32; ++d)
#pragma unroll
        for (int i = 0; i < 16; ++i) O[d][i] *= alpha;
      L[0] *= alpha;
    }
    m = mn;
    const float nm = -mn;
#pragma unroll
    for (int u = 0; u < NSUB; ++u) {
      S[u] = S[u] + nm;
#pragma unroll
      for (int i = 0; i < 16; ++i) S[u][i] = exp2f_fast(S[u][i]);
    }
#pragma unroll
    for (int u = 0; u < NSUB; ++u) {
      bf16x8 pf[2];
#pragma unroll
      for (int s = 0; s < 2; ++s) {
        uint4 w;
        w.x = pack2(S[u][8 * s + 0], S[u][8 * s + 1]); w.y = pack2(S[u][8 * s + 2], S[u][8 * s + 3]);
        w.z = pack2(S[u][8 * s + 4], S[u][8 * s + 5]); w.w = pack2(S[u][8 * s + 6], S[u][8 * s + 7]);
        pf[s] = __builtin_bit_cast(bf16x8, w);
      }
#pragma unroll
      for (int s = 0; s < 2; ++s) L = MFMA32(onesf, pf[s], L);
#pragma unroll
      for (int d = 0; d < DV / 32; ++d)
#pragma unroll
        for (int s = 0; s < 2; ++s) {
          const bf16x8 vf = *(const bf16x8*)(st + voff + d * 32 * (LAYER ? 64 : 128) + (((4 * u + 2 * s + h) ^ vsw) * 16));
          O[d] = MFMA32(vf, pf[s], O[d]);
        }
    }
  }
#undef TKEY
  l_out = L[0];
}

DI void attn0_phase(const Params& p, unsigned char* smem, int cidx) {
  const int tid = threadIdx.x, lane = tid & 63, wave = tid >> 6;
  int* cnt = (int*)(p.ws + OFF_CNT) + cidx;
  int* s_item = (int*)(smem + 65536);
  const u16* Q = (const u16*)(p.ws + OFF_Q);
  const u16* G = (const u16*)(p.ws + OFF_G);
  u16* AO = (u16*)(p.ws + OFF_AO);
  for (int round = 0;; ++round) {
    if (tid == 0) *s_item = round == 0 ? (int)blockIdx.x : (int)gridDim.x + atomicAdd(cnt, 1);
    __syncthreads();
    const int item = *s_item;
    __syncthreads();
    if (item >= 768) break;
    int br, row0, head, vs, tb1, te1, tb2 = 0, te2 = 0, qpos0 = 0;
    bool use_mask = false;
    const u16 *Kp, *Vp;
    if (item < 256) {
      br = item >> 7;
      const int r = item & 127, b = r >> 6, kvh = (r >> 5) & 1, qb = r & 31;
      head = kvh * 4 + wave;
      row0 = M_CTX + b * 1024 + qb * 32;
      Kp = (const u16*)(p.ws + (br ? OFF_KSB : OFF_KSA)) + (size_t)(b * 2 + kvh) * 1280 * 64;
      Vp = (const u16*)(p.ws + (br ? OFF_VSB : OFF_VSA)) + (size_t)(b * 2 + kvh) * 64 * 1280;
      vs = 1280;
      if (br == 0) { tb1 = 0; te1 = 20; }
      else {
        const int q0 = qb * 32;
        tb1 = q0 >= 128 ? (q0 - 128) >> 6 : 0;
        te1 = ((q0 + 159) >> 6) + 1; if (te1 > 16) te1 = 16;
        tb2 = 16; te2 = 20; use_mask = true; qpos0 = q0;
      }
    } else {
      int r = item - 256;
      br = r >> 8; r &= 255;
      const int b = r >> 4, kvh = (r >> 3) & 1, qb = r & 7;
      head = kvh * 4 + wave;
      row0 = b * 256 + qb * 32;
      Kp = (const u16*)(p.ws + (br ? OFF_KCB : OFF_KCA)) + (size_t)(b * 2 + kvh) * 256 * 64;
      Vp = (const u16*)(p.ws + (br ? OFF_VCB : OFF_VCA)) + (size_t)(b * 2 + kvh) * 64 * 256;
      vs = 256; tb1 = 0; te1 = 4;
    }
    const float m_init = br ? p.in[I_SINK][head] * LOG2E : -1e30f;
    const float l_init = br ? 1.0f : 0.0f;
    const int col0 = br * 512 + head * 64;
    f32x16 O[2];
    float l;
    flash_lds<0>(Q + (size_t)row0 * 1024 + col0, smem, Kp, Kp, Vp, vs, 0, tb1, te1, tb2, te2, use_mask, qpos0, m_init, l_init, O, l);
    const float inv = 1.0f / l;
    const int row = row0 + (lane & 31), h = lane >> 5;
#pragma unroll
    for (int d = 0; d < 2; ++d)
#pragma unroll
      for (int g = 0; g < 4; ++g) {
        const size_t o = (size_t)row * 1024 + col0 + d * 32 + 8 * g + 4 * h;
        const uint2 gv = *(const uint2*)(G + o);
        uint2 ov;
        ov.x = pack2(O[d][4 * g + 0] * inv * bflo(gv.x), O[d][4 * g + 1] * inv * bfhi(gv.x));
        ov.y = pack2(O[d][4 * g + 2] * inv * bflo(gv.y), O[d][4 * g + 3] * inv * bfhi(gv.y));
        st8_wt(AO + o, ov);
      }
  }
}

DI void attn1_phase(const Params& p, unsigned char* smem, int cidx) {
  const int tid = threadIdx.x, lane = tid & 63, wave = tid >> 6;
  int* cnt = (int*)(p.ws + OFF_CNT) + cidx;
  int* s_item = (int*)(smem + 65536);
  const u16* Q = (const u16*)(p.ws + OFF_Q);
  const u16* G = (const u16*)(p.ws + OFF_G);
  u16* AO = (u16*)(p.ws + OFF_AO);
  float* xch = (float*)smem;
  float lam;
  {
    const float a = p.in[I_LQ1][lane] * p.in[I_LK1][lane];
    const float b = p.in[I_LQ2][lane] * p.in[I_LK2][lane];
    lam = __expf(wave_sum(a)) - __expf(wave_sum(b)) + LAM_INIT;
  }
  const int map = wave & 1, qsub = wave >> 1;
  for (int round = 0;; ++round) {
    if (tid == 0) *s_item = round == 0 ? (int)blockIdx.x : (int)gridDim.x + atomicAdd(cnt, 1);
    __syncthreads();
    const int item = *s_item;
    __syncthreads();
    if (item >= 768) break;
    int row0, head, vs, te1;
    const u16 *Kp, *Vp;
    if (item < 256) {
      const int b = item >> 7, hd = (item >> 4) & 7, qb = item & 15;
      head = hd;
      row0 = M_CTX + b * 1024 + qb * 64 + qsub * 32;
      Kp = (const u16*)(p.ws + OFF_KSC) + (size_t)(b * 16 + hd * 2) * 1280 * 64;
      Vp = (const u16*)(p.ws + OFF_VSC) + (size_t)(b * 8 + hd) * 128 * 1280;
      vs = 1280; te1 = 40;
    } else {
      const int r = item - 256, b = r >> 5, hd = (r >> 2) & 7, qb = r & 3;
      head = hd;
      row0 = b * 256 + qb * 64 + qsub * 32;
      Kp = (const u16*)(p.ws + OFF_KCC) + (size_t)(b * 16 + hd * 2) * 256 * 64;
      Vp = (const u16*)(p.ws + OFF_VCC) + (size_t)(b * 8 + hd) * 128 * 256;
      vs = 256; te1 = 8;
    }
    f32x16 O[4];
    float l;
    flash_lds<1>(Q + (size_t)row0 * 1024 + (head * 2 + map) * 64, smem, Kp, Kp + (size_t)vs * 64, Vp, vs, map,
                 0, te1, 0, 0, false, 0, -1e30f, 0.0f, O, l);
    const float inv = 1.0f / l;
    __syncthreads();
    if (map == 1) {
#pragma unroll
      for (int d = 0; d < 4; ++d)
#pragma unroll
        for (int i = 0; i < 16; ++i) xch[(qsub * 64 + d * 16 + i) * 64 + lane] = O[d][i] * inv;
    }
    __syncthreads();
    if (map == 0) {
      float ss = 0.f;
#pragma unroll
      for (int d = 0; d < 4; ++d)
#pragma unroll
        for (int i = 0; i < 16; ++i) {
          const float o = O[d][i] * inv - lam * xch[(qsub * 64 + d * 16 + i) * 64 + lane];
          O[d][i] = o;
          ss += o * o;
        }
      ss += __shfl_xor(ss, 32);
      const float rr = rsqrtf(ss * (1.0f / 128.0f) + EPS) * (1.0f - LAM_INIT);
      const int row = row0 + (lane & 31), h = lane >> 5;
      const float* sw = p.in[I_SUBLN];
#pragma unroll
      for (int d = 0; d < 4; ++d)
#pragma unroll
        for (int g = 0; g < 4; ++g) {
          const int dv = d * 32 + 8 * g + 4 * h;
          const size_t o = (size_t)row * 1024 + head * 128 + dv;
          const uint2 gv = *(const uint2*)(G + o);
          const float4 w4 = *(const float4*)(sw + dv);
          uint2 ov;
          ov.x = pack2(O[d][4 * g + 0] * rr * w4.x * bflo(gv.x), O[d][4 * g + 1] * rr * w4.y * bfhi(gv.x));
          ov.y = pack2(O[d][4 * g + 2] * rr * w4.z * bflo(gv.y), O[d][4 * g + 3] * rr * w4.w * bfhi(gv.y));
          st8_wt(AO + o, ov);
        }
    }
  }
}

DI unsigned bar_ld(unsigned* p) { return __hip_atomic_load(p, __ATOMIC_RELAXED, __HIP_MEMORY_SCOPE_AGENT); }
DI unsigned bar_add(unsigned* p, unsigned v) { return __hip_atomic_fetch_add(p, v, __ATOMIC_RELAXED, __HIP_MEMORY_SCOPE_AGENT); }
DI void grid_bar(unsigned* bar, unsigned& epoch) {
  asm volatile("s_waitcnt vmcnt(0)" ::: "memory");
  __syncthreads();
  if (threadIdx.x == 0) {
    epoch += 1;
    __builtin_amdgcn_fence(__ATOMIC_RELEASE, "agent");
    asm volatile("s_waitcnt vmcnt(0)" ::: "memory");
    const unsigned ng = gridDim.x < 8 ? gridDim.x : 8;
    const unsigned grp = blockIdx.x % ng;
    const unsigned nloc = (gridDim.x - grp + ng - 1) / ng;
    const unsigned old = bar_add(&bar[64 * (1 + grp)], 1u);
    if (old + 1u == epoch * nloc) {
      const unsigned o2 = bar_add(&bar[0], 1u);
      if (o2 + 1u == epoch * ng) __hip_atomic_store(&bar[64 * 9], epoch, __ATOMIC_RELAXED, __HIP_MEMORY_SCOPE_AGENT);
    }
    while (bar_ld(&bar[64 * 9]) < epoch) __builtin_amdgcn_s_sleep(1);
    __builtin_amdgcn_fence(__ATOMIC_ACQUIRE, "agent");
    asm volatile("s_waitcnt vmcnt(0)" ::: "memory");
  }
  __syncthreads();
}

#define XB_TMO      128
#define XB_XCNT(j)  (256  + 64 * (j))
#define XB_XSUB(j)  (1280 + 64 * (j))
#define XB_XGEN(j)  (2304 + 64 * (j))
#define XB_TOP      3328
#define XB_TOPGEN   3392
#define XCD_BAR_WORDS 3456
#define XB_SPIN_CAP (1u << 18)
#define LAS __attribute__((address_space(3)))

__device__ __forceinline__ unsigned xb_ld(unsigned* p)              { return __hip_atomic_load(p, __ATOMIC_RELAXED, __HIP_MEMORY_SCOPE_AGENT); }
__device__ __forceinline__ unsigned xb_add(unsigned* p, unsigned v) { return __hip_atomic_fetch_add(p, v, __ATOMIC_RELAXED, __HIP_MEMORY_SCOPE_AGENT); }
__device__ __forceinline__ unsigned xb_xcc_id() { return (unsigned)__builtin_amdgcn_s_getreg((3 << 11) | 20) & 0xFu; }
#define XB_SPIN(cond, bar) do { unsigned _sp = 0; while (cond) { __builtin_amdgcn_s_sleep(1); \
    if ((++_sp & 255u) == 0u) { if (xb_ld(&(bar)[XB_TMO])) break; if (_sp > XB_SPIN_CAP) { atomicAdd(&(bar)[XB_TMO], 1u); break; } } } } while (0)

struct XcdBarrier {
    unsigned* bar; unsigned x;
    volatile LAS unsigned* st;
};

__device__ __forceinline__ XcdBarrier xcd_barrier_post(unsigned* bar, volatile LAS unsigned* st) {
    XcdBarrier b; b.bar = bar; b.x = xb_xcc_id(); b.st = st;
    if (threadIdx.x == 0) (void)xb_add(&bar[XB_XCNT(b.x)], 1u);
    return b;
}
__device__ __forceinline__ void xcd_barrier_complete(unsigned* bar, unsigned x, unsigned& nloc, unsigned& nx) {
    const unsigned G = gridDim.x * gridDim.y * gridDim.z;
    unsigned sum, cnt, mine, sp = 0u;
    for (;;) {
        sum = 0u; cnt = 0u; mine = 0u;
#pragma unroll
        for (unsigned j = 0; j < 16; ++j) { const unsigned c = xb_ld(&bar[XB_XCNT(j)]); sum += c; cnt += (c > 0u) ? 1u : 0u; mine = (j == x) ? c : mine; }
        if (sum == G) break;
        __builtin_amdgcn_s_sleep(1);
        if ((++sp & 255u) == 0u) { if (xb_ld(&bar[XB_TMO])) break; if (sp > XB_SPIN_CAP) { atomicAdd(&bar[XB_TMO], 1u); break; } }
    }
    nloc = mine > 0u ? mine : 1u; nx = cnt > 0u ? cnt : 1u;
}

__device__ __forceinline__ void xcd_barrier(const XcdBarrier& b) {
    asm volatile("s_waitcnt vmcnt(0)" ::: "memory");
    __syncthreads();
    if (threadIdx.x == 0) {
        unsigned* bar = b.bar;
        __builtin_amdgcn_s_waitcnt(0);
        unsigned nloc = b.st[0], nx = b.st[1];
        if (nloc == 0u) { xcd_barrier_complete(bar, b.x, nloc, nx); b.st[0] = nloc; b.st[1] = nx; }
        const unsigned old = xb_add(&bar[XB_XSUB(b.x)], 1u);
        const unsigned gen = old / nloc;
        if (old + 1u == (gen + 1u) * nloc) {
            __builtin_amdgcn_fence(__ATOMIC_RELEASE, "agent");
            asm volatile("s_waitcnt vmcnt(0)" ::: "memory");
            const unsigned og = xb_add(&bar[XB_TOP], 1u);
            const unsigned tg = og / nx;
            if (og + 1u == (tg + 1u) * nx) xb_add(&bar[XB_TOPGEN], 1u);
            else XB_SPIN(xb_ld(&bar[XB_TOPGEN]) == tg, bar);
            __builtin_amdgcn_fence(__ATOMIC_ACQUIRE, "agent");
            xb_add(&bar[XB_XGEN(b.x)], 1u);
            asm volatile("s_waitcnt vmcnt(0)" ::: "memory");
        } else {
            XB_SPIN(xb_ld(&bar[XB_XGEN(b.x)]) == gen, bar);
            __builtin_amdgcn_fence(__ATOMIC_ACQUIRE, "agent");
            asm volatile("s_waitcnt vmcnt(0)" ::: "memory");
        }
    }
    __syncthreads();
}

__global__ void __launch_bounds__(256, 2) mega(Params p) {
  extern __shared__ __attribute__((aligned(16))) unsigned char smem[];
  cg::grid_group grid = cg::this_grid();
  unsigned* bar = (unsigned*)(p.ws + OFF_BAR);
  unsigned epoch = 0; (void)epoch;
  volatile LAS unsigned* xb_st = (volatile LAS unsigned*)(smem + 65536 + 16);
  if (threadIdx.x == 0) { xb_st[0] = 0u; xb_st[1] = 0u; }
  __syncthreads();
  XcdBarrier xb = xcd_barrier_post(bar, xb_st);
#define grid_bar(b_, e_) xcd_barrier(xb)
  if (p.ph_hi > 1000) grid.sync();
  int cidx = 0;
#define PHASE(k, call) if (p.ph_lo <= (k) && (k) < p.ph_hi) { { const bool EPI_ON = true; (void)EPI_ON; call; } if ((REP_MASK >> (k)) & 1) { const bool EPI_ON = (REP_EPI != 0); (void)EPI_ON; grid_bar(bar, epoch); call; } if ((k) + 1 < p.ph_hi) grid_bar(bar, epoch); }
  const bool fuse_ln = (p.ph_hi - p.ph_lo == 10) && (((gridDim.x & 7) == 0) ? ((gridDim.x >> 3) >= 48) : (gridDim.x >= 384));
  PHASE(0, phase0(p, smem))
  PHASE(1, phase_h0(p))
  PHASE(2, gemm_phase<EPI_IN0>(p, smem, (const u16*)(p.ws + OFF_H), (const u16*)(p.ws + OFF_WIN0), 2560, EPI_ON))
  PHASE(3, attn0_phase(p, smem, cidx++))
  PHASE(4, gemm_phase<EPI_OUT0>(p, smem, (const u16*)(p.ws + OFF_AO), (const u16*)(p.ws + OFF_WOUT0), 1024, EPI_ON, fuse_ln))
  if (!fuse_ln) { PHASE(5, phase_ln<false>(p)) }
  PHASE(6, gemm_phase<EPI_IN1>(p, smem, (const u16*)(p.ws + OFF_H), (const u16*)(p.ws + OFF_WIN1), 4096, EPI_ON))
  PHASE(7, attn1_phase(p, smem, cidx++))
  if (fuse_ln) {
    if (p.ph_lo <= 8 && 8 < p.ph_hi) gemm_phase<EPI_OUT1>(p, smem, (const u16*)(p.ws + OFF_AO), (const u16*)(p.ws + OFF_WOUT1), 1024, true, true);
  } else {
    PHASE(8, gemm_phase<EPI_OUT1>(p, smem, (const u16*)(p.ws + OFF_AO), (const u16*)(p.ws + OFF_WOUT1), 1024, EPI_ON, false))
    PHASE(9, phase_ln<true>(p))
  }
}

extern "C" void kernel_launch(void* const* d_in, const int* in_sizes, int n_in, void* d_out, int out_size, void* d_ws,
                              size_t ws_size, hipStream_t stream) {
  static int grid_blocks = 0;
  if (!grid_blocks) {
    int dev = 0, cus = 0, per_cu = 0;
    (void)hipGetDevice(&dev);
    (void)hipDeviceGetAttribute(&cus, hipDeviceAttributeMultiprocessorCount, dev);
    if (hipFuncSetAttribute((const void*)mega, hipFuncAttributeMaxDynamicSharedMemorySize, LDS_BYTES) != hipSuccess)
      fprintf(stderr, "kernel_launch: hipFuncSetAttribute failed\n");
    if (hipOccupancyMaxActiveBlocksPerMultiprocessor(&per_cu, (const void*)mega, 256, LDS_BYTES) != hipSuccess || per_cu < 1) {
      fprintf(stderr, "kernel_launch: occupancy query gave %d\n", per_cu);
      per_cu = 1;
    }
    (void)hipGetLastError();
    if (per_cu > 2) per_cu = 2;
    if (cus <= 0) cus = 256;
    grid_blocks = cus * per_cu;
    if (ws_size < WS_END) fprintf(stderr, "kernel_launch: workspace too small\n");
  }
  (void)hipMemsetAsync((unsigned char*)d_ws + OFF_BAR, 0, BAR_BYTES, stream);
  Params p{};
  for (int i = 0; i < 26; ++i) p.in[i] = (const float*)d_in[i];
  p.out = (float*)d_out;
  p.ws = (unsigned char*)d_ws;
#if N_LAUNCH_MULTI
  for (int ph = 0; ph < 10; ++ph) {
    p.ph_lo = ph; p.ph_hi = ph + 1;
    hipLaunchKernelGGL(mega, dim3(grid_blocks), dim3(256), LDS_BYTES, stream, p);
  }
#else
  p.ph_lo = 0; p.ph_hi = 10;
  void* args[] = {&p};
  hipError_t e = hipLaunchCooperativeKernel((void*)mega, dim3(grid_blocks), dim3(256), args, LDS_BYTES, stream);
  if (e != hipSuccess) fprintf(stderr, "cooperative launch failed: %s (grid %d)\n", hipGetErrorString(e), grid_blocks);
#endif
}
```

```cpp
#include <hip/hip_runtime.h>
#include <hip/hip_cooperative_groups.h>
#include <cstdio>
namespace cg = cooperative_groups;

#ifndef GEMM_SKEW
#define GEMM_SKEW 0
#endif
#ifndef REP_EPI
#define REP_EPI 1
#endif
#ifndef REP_MASK
#define REP_MASK 0
#endif
#ifndef N_LAUNCH_MULTI
#define N_LAUNCH_MULTI 0
#endif

#define DI __device__ __forceinline__
typedef unsigned short u16;
using bf16x8 = __attribute__((ext_vector_type(8))) short;
using f32x4 = __attribute__((ext_vector_type(4))) float;
using f32x16 = __attribute__((ext_vector_type(16))) float;
typedef __bf16 bf2_t __attribute__((ext_vector_type(2)));
typedef float f2_t __attribute__((ext_vector_type(2)));

#define MFMA16(a, b, c) __builtin_amdgcn_mfma_f32_16x16x32_bf16((a), (b), (c), 0, 0, 0)
#define MFMA32(a, b, c) __builtin_amdgcn_mfma_f32_32x32x16_bf16((a), (b), (c), 0, 0, 0)

constexpr int M_CTX = 4096, M_ALL = 6144;
constexpr float ALPHA = 1.4142135623730951f;
constexpr float EPS = 1e-6f;
constexpr float LOG2E = 1.4426950408889634f;
constexpr float QSCALE = 0.125f * LOG2E;
constexpr float LAM_INIT = 0.35550906759096926f;

enum { I_XP = 0, I_XS, I_CAK, I_CAV, I_CBK, I_CBV, I_CCK, I_CCV, I_C, I_CCTX, I_WMOD, I_BMOD, I_LNG, I_LNB,
       I_WINE, I_WOUTE, I_QNA, I_KNA, I_SINK, I_WINO, I_WOUTO, I_LQ1, I_LK1, I_LQ2, I_LK2, I_SUBLN };

constexpr size_t O_YP = 0, O_YS = 4194304, O_AK = 6291456, O_AV = 6815744, O_BK = 7340032, O_BV = 7864320,
                 O_CK = 8388608, O_CV = 12582912;

constexpr size_t OFF_MOD = 0;
constexpr size_t OFF_ROPE = OFF_MOD + 73728;
constexpr size_t OFF_CNT = OFF_ROPE + 262144;
constexpr size_t OFF_WIN0 = OFF_CNT + 256;
constexpr size_t OFF_WOUT0 = OFF_WIN0 + 5242880;
constexpr size_t OFF_WIN1 = OFF_WOUT0 + 2097152;
constexpr size_t OFF_WOUT1 = OFF_WIN1 + 8388608;
constexpr size_t OFF_H = OFF_WOUT1 + 2097152;
constexpr size_t OFF_Q = OFF_H + 12582912;
constexpr size_t OFF_G = OFF_Q + 12582912;
constexpr size_t OFF_AO = OFF_G + 12582912;
constexpr size_t OFF_KCA = OFF_AO + 12582912;
constexpr size_t OFF_VCA = OFF_KCA + 1048576;
constexpr size_t OFF_KCB = OFF_VCA + 1048576;
constexpr size_t OFF_VCB = OFF_KCB + 1048576;
constexpr size_t OFF_KSA = OFF_VCB + 1048576;
constexpr size_t OFF_VSA = OFF_KSA + 655360;
constexpr size_t OFF_KSB = OFF_VSA + 655360;
constexpr size_t OFF_VSB = OFF_KSB + 655360;
constexpr size_t OFF_KCC = OFF_VSB + 655360;
constexpr size_t OFF_VCC = OFF_KCC + 8388608;
constexpr size_t OFF_KSC = OFF_VCC + 8388608;
constexpr size_t OFF_VSC = OFF_KSC + 5242880;
constexpr size_t OFF_R = OFF_VSC + 5242880;
constexpr size_t OFF_X1 = OFF_R + 25165824;
constexpr size_t OFF_BAR = OFF_X1 + 25165824;
constexpr size_t BAR_BYTES = 16384;
constexpr size_t OFF_PART = OFF_BAR + BAR_BYTES;
constexpr size_t WS_END = OFF_PART + 786432;
constexpr int BANDCNT_WORD = 3500;

constexpr int LDS_BYTES = 2 * 2 * 128 * 64 * 2 + 64;

struct Params {
  const float* in[26];
  float* out;
  unsigned char* ws;
  int ph_lo, ph_hi;
};

DI unsigned pack2(float a, float b) {
  f2_t v = {a, b};
  bf2_t r = __builtin_convertvector(v, bf2_t);
  return __builtin_bit_cast(unsigned, r);
}
DI u16 f2bf(float x) { return (u16)(pack2(x, 0.f) & 0xffffu); }
DI float bflo(unsigned u) { return __uint_as_float(u << 16); }
DI float bfhi(unsigned u) { return __uint_as_float(u & 0xffff0000u); }
DI float exp2f_fast(float x) { return __builtin_amdgcn_exp2f(x); }
DI float silu(float x) { return x * __builtin_amdgcn_rcpf(1.0f + __expf(-x)); }
typedef unsigned u32x4_t __attribute__((ext_vector_type(4)));
DI void st16_wt_raw(void* p, u32x4_t v) {
  asm volatile("global_store_dwordx4 %0, %1, off sc1\n\ts_nop 1" :: "v"(p), "v"(v) : "memory");
}
DI void st16_wt(void* p, uint4 v) { st16_wt_raw(p, u32x4_t{v.x, v.y, v.z, v.w}); }
DI void st16_wt(void* p, float4 v) {
  st16_wt_raw(p, u32x4_t{__float_as_uint(v.x), __float_as_uint(v.y), __float_as_uint(v.z), __float_as_uint(v.w)});
}
DI void st8_wt(void* p, uint2 v) {
  __hip_atomic_store((unsigned long long*)p, ((unsigned long long)v.y << 32) | v.x, __ATOMIC_RELAXED, __HIP_MEMORY_SCOPE_AGENT);
}
DI float wave_sum(float v) {
  v += __shfl_xor(v, 32); v += __shfl_xor(v, 16); v += __shfl_xor(v, 8);
  v += __shfl_xor(v, 4); v += __shfl_xor(v, 2); v += __shfl_xor(v, 1);
  return v;
}
DI float sum16(float v) {
  v += __shfl_xor(v, 8); v += __shfl_xor(v, 4); v += __shfl_xor(v, 2); v += __shfl_xor(v, 1);
  return v;
}
DI const float* xrow(const Params& p, int row) {
  return row < M_CTX ? p.in[I_XP] + (size_t)row * 1024 : p.in[I_XS] + (size_t)(row - M_CTX) * 1024;
}
DI int modvec(int row) { return row < M_CTX ? 0 : 1 + ((row - M_CTX) >> 10); }

DI void prep_item(const Params& p, unsigned char* smem, int item, int tid) {
  float* fs = (float*)smem;
  {
    if (item < 192) {
      const int l = item / 96, n0 = (item % 96) * 32;
      const int cq = tid & 7, kg = tid >> 3;
      const float* W = p.in[I_WMOD] + (size_t)l * 1024 * 3072 + n0 + cq * 4;
      const float* cc = p.in[I_CCTX];
      const float* c1 = p.in[I_C];
      float a0[4] = {0, 0, 0, 0}, a1[4] = {0, 0, 0, 0}, a2[4] = {0, 0, 0, 0};
      float* sl = fs + 4096;
#pragma unroll
      for (int j = 0; j < 12; ++j) {
        const int idx = tid + 256 * j, v = idx >> 10, k = idx & 1023;
        sl[idx] = silu(v == 0 ? cc[k] : c1[(v - 1) * 1024 + k]);
      }
      __syncthreads();
#pragma unroll 16
      for (int i = 0; i < 32; ++i) {
        const int k = kg * 32 + i;
        const f32x4 wv_ = __builtin_nontemporal_load((const f32x4*)(W + (size_t)k * 3072)); const float4 w = {wv_[0], wv_[1], wv_[2], wv_[3]};
        const float s0 = sl[k], s1 = sl[1024 + k], s2 = sl[2048 + k];
        a0[0] += s0 * w.x; a0[1] += s0 * w.y; a0[2] += s0 * w.z; a0[3] += s0 * w.w;
        a1[0] += s1 * w.x; a1[1] += s1 * w.y; a1[2] += s1 * w.z; a1[3] += s1 * w.w;
        a2[0] += s2 * w.x; a2[1] += s2 * w.y; a2[2] += s2 * w.z; a2[3] += s2 * w.w;
      }
#pragma unroll
      for (int e = 0; e < 4; ++e) {
        fs[kg * 96 + 0 + cq * 4 + e] = a0[e];
        fs[kg * 96 + 32 + cq * 4 + e] = a1[e];
        fs[kg * 96 + 64 + cq * 4 + e] = a2[e];
      }
      __syncthreads();
      if (tid < 96) {
        float s = 0;
        for (int g = 0; g < 32; ++g) s += fs[g * 96 + tid];
        const int v = tid >> 5, col = n0 + (tid & 31);
        s += p.in[I_BMOD][l * 3072 + col];
        ((float*)(p.ws + OFF_MOD))[(l * 3 + v) * 3072 + col] = s;
      }
      __syncthreads();
    } else {
      int t = item - 192;
      const float* W; u16* Wt; int N;
      if (t < 640) { W = p.in[I_WINE]; Wt = (u16*)(p.ws + OFF_WIN0); N = 2560; }
      else if (t < 896) { t -= 640; W = p.in[I_WOUTE]; Wt = (u16*)(p.ws + OFF_WOUT0); N = 1024; }
      else if (t < 1920) { t -= 896; W = p.in[I_WINO]; Wt = (u16*)(p.ws + OFF_WIN1); N = 4096; }
      else { t -= 1920; W = p.in[I_WOUTO]; Wt = (u16*)(p.ws + OFF_WOUT1); N = 1024; }
      const int nt = N / 64;
      const int k0 = (t / nt) * 64, n0 = (t % nt) * 64;
#pragma unroll
      for (int i = 0; i < 4; ++i) {
        const int idx = tid + 256 * i;
        const int row = idx >> 4, c4 = idx & 15;
        const f32x4 wv_ = __builtin_nontemporal_load((const f32x4*)(W + (size_t)(k0 + row) * N + n0 + c4 * 4)); const float4 w = {wv_[0], wv_[1], wv_[2], wv_[3]};
        fs[row * 65 + c4 * 4 + 0] = w.x; fs[row * 65 + c4 * 4 + 1] = w.y;
        fs[row * 65 + c4 * 4 + 2] = w.z; fs[row * 65 + c4 * 4 + 3] = w.w;
      }
      __syncthreads();
#pragma unroll
      for (int i = 0; i < 2; ++i) {
        const int idx = tid + 256 * i;
        const int n = idx >> 3, kc = idx & 7;
        uint4 o;
        o.x = pack2(fs[(kc * 8 + 0) * 65 + n], fs[(kc * 8 + 1) * 65 + n]);
        o.y = pack2(fs[(kc * 8 + 2) * 65 + n], fs[(kc * 8 + 3) * 65 + n]);
        o.z = pack2(fs[(kc * 8 + 4) * 65 + n], fs[(kc * 8 + 5) * 65 + n]);
        o.w = pack2(fs[(kc * 8 + 6) * 65 + n], fs[(kc * 8 + 7) * 65 + n]);
        st16_wt(Wt + (size_t)(n0 + n) * 1024 + k0 + kc * 8, o);
      }
      __syncthreads();
    }
  }
}
DI void phase0(const Params& p, unsigned char* smem) {
  const int tid = threadIdx.x;
  const int b = blockIdx.x, nb = gridDim.x;
  for (int item = b; item < 192; item += nb) prep_item(p, smem, item, tid);
  if (nb >= 384) {
    if (b < 192) { prep_item(p, smem, 192 + b, tid); prep_item(p, smem, 192 + 192 + b, tid); }
    else for (int t = 384 + (b - 192); t < 2176; t += nb - 192) prep_item(p, smem, 192 + t, tid);
  } else {
    for (int t = b; t < 2176; t += nb) prep_item(p, smem, 192 + t, tid);
  }
  const int gtid = blockIdx.x * 256 + tid, gsz = gridDim.x * 256;
  if (gtid < 64) ((int*)(p.ws + OFF_CNT))[gtid] = 0;
  float* tab = (float*)(p.ws + OFF_ROPE);
  for (int idx = gtid; idx < 1024 * 32; idx += gsz) {
    const int s = idx >> 5, i = idx & 31, which = i >> 4, fi = i & 15;
    const float pos = (float)(which ? (s & 63) : (s >> 6));
    const float freq = exp2f(-(float)fi * (13.287712379549449f / 16.0f));
    float tr = pos * freq * 0.15915494309189535f;
    tr = tr - floorf(tr);
    tab[s * 64 + which * 32 + fi] = __builtin_amdgcn_cosf(tr);
    tab[s * 64 + which * 32 + 16 + fi] = __builtin_amdgcn_sinf(tr);
  }
  for (int idx = gtid; idx < 2 * 256 * 128; idx += gsz) {
    const int b = idx >> 15, s = (idx >> 7) & 255, kvh = (idx >> 6) & 1, d = idx & 63;
    const size_t ko = ((size_t)(b * 2 + kvh) * 1280 + 1024 + s) * 64 + d;
    const size_t vo = ((size_t)(b * 2 + kvh) * 64 + d) * 1280 + 1024 + s;
    ((u16*)(p.ws + OFF_KSA))[ko] = f2bf(p.in[I_CAK][idx]);
    ((u16*)(p.ws + OFF_VSA))[vo] = f2bf(p.in[I_CAV][idx]);
    ((u16*)(p.ws + OFF_KSB))[ko] = f2bf(p.in[I_CBK][idx]);
    ((u16*)(p.ws + OFF_VSB))[vo] = f2bf(p.in[I_CBV][idx]);
  }
  for (int idx = gtid; idx < 2 * 256 * 1024; idx += gsz) {
    const int b = idx >> 18, s = (idx >> 10) & 255, col = idx & 1023;
    const int hh = col >> 6, d = col & 63, head = col >> 7, dv = col & 127;
    ((u16*)(p.ws + OFF_KSC))[((size_t)(b * 16 + hh) * 1280 + 1024 + s) * 64 + d] = f2bf(p.in[I_CCK][idx]);
    ((u16*)(p.ws + OFF_VSC))[(size_t)(b * 8 + head) * 128 * 1280 + ((size_t)((1024 + s) >> 5) * 128 + dv) * 32 + (s & 31)] = f2bf(p.in[I_CCV][idx]);
  }
}

DI void phase_h0(const Params& p) {
  const int gtid = blockIdx.x * 256 + threadIdx.x, gsz = gridDim.x * 256;
  const float* mod = (const float*)(p.ws + OFF_MOD);
  u16* H = (u16*)(p.ws + OFF_H);
  for (int idx = gtid; idx < M_ALL * 128; idx += gsz) {
    const int row = idx >> 7, c = (idx & 127) * 8;
    const float* x = xrow(p, row) + c;
    const float* mv = mod + modvec(row) * 3072;
    const float4 x0 = *(const float4*)x, x1 = *(const float4*)(x + 4);
    const float4 sh0 = *(const float4*)(mv + c), sh1 = *(const float4*)(mv + c + 4);
    const float4 sc0 = *(const float4*)(mv + 1024 + c), sc1 = *(const float4*)(mv + 1024 + c + 4);
    uint4 o;
    o.x = pack2(x0.x * (1.f + sc0.x) + sh0.x, x0.y * (1.f + sc0.y) + sh0.y);
    o.y = pack2(x0.z * (1.f + sc0.z) + sh0.z, x0.w * (1.f + sc0.w) + sh0.w);
    o.z = pack2(x1.x * (1.f + sc1.x) + sh1.x, x1.y * (1.f + sc1.y) + sh1.y);
    o.w = pack2(x1.z * (1.f + sc1.z) + sh1.z, x1.w * (1.f + sc1.w) + sh1.w);
    st16_wt(H + (size_t)row * 1024 + c, o);
  }
}

template <bool FINAL>
DI void phase_ln(const Params& p) {
  const int lane = threadIdx.x & 63;
  const int gw = blockIdx.x * 4 + (threadIdx.x >> 6), nw = gridDim.x * 4;
  const int l = FINAL ? 1 : 0;
  const float* R = (const float*)(p.ws + OFF_R);
  const float* g = p.in[I_LNG] + l * 1024;
  const float* bb = p.in[I_LNB] + l * 1024;
  for (int row = gw; row < M_ALL; row += nw) {
    float4 v[4];
    float s = 0;
#pragma unroll
    for (int i = 0; i < 4; ++i) {
      v[i] = *(const float4*)(R + (size_t)row * 1024 + i * 256 + lane * 4);
      s += v[i].x + v[i].y + v[i].z + v[i].w;
    }
    const float mu = wave_sum(s) * (1.0f / 1024.0f);
    float q = 0;
#pragma unroll
    for (int i = 0; i < 4; ++i) {
      v[i].x -= mu; v[i].y -= mu; v[i].z -= mu; v[i].w -= mu;
      q += v[i].x * v[i].x + v[i].y * v[i].y + v[i].z * v[i].z + v[i].w * v[i].w;
    }
    const float rs = rsqrtf(wave_sum(q) * (1.0f / 1024.0f) + EPS);
#pragma unroll
    for (int i = 0; i < 4; ++i) {
      const int c = i * 256 + lane * 4;
      const float4 gg = *(const float4*)(g + c), be = *(const float4*)(bb + c);
      float4 y;
      y.x = v[i].x * rs * gg.x + be.x; y.y = v[i].y * rs * gg.y + be.y;
      y.z = v[i].z * rs * gg.z + be.z; y.w = v[i].w * rs * gg.w + be.w;
      if (FINAL) {
        st16_wt(p.out + (size_t)row * 1024 + c, y);
      } else {
        st16_wt((float*)(p.ws + OFF_X1) + (size_t)row * 1024 + c, y);
        const float* mv = (const float*)(p.ws + OFF_MOD) + (3 + modvec(row)) * 3072;
        const float4 sh = *(const float4*)(mv + c), sc = *(const float4*)(mv + 1024 + c);
        uint2 o;
        o.x = pack2(y.x * (1.f + sc.x) + sh.x, y.y * (1.f + sc.y) + sh.y);
        o.y = pack2(y.z * (1.f + sc.z) + sh.z, y.w * (1.f + sc.w) + sh.w);
        st8_wt((u16*)(p.ws + OFF_H) + (size_t)row * 1024 + c, o);
      }
    }
  }
}

DI void rope_T(const Params& p, f32x4 (&acc)[4][4], int rbase, int lane) {
  const float* tab = (const float*)(p.ws + OFF_ROPE);
  const int l15 = lane & 15, f0 = (lane >> 4) * 4;
#pragma unroll
  for (int mi = 0; mi < 4; ++mi) {
    const int s = (rbase + mi * 16 + l15 - M_CTX) & 1023;
    const float* t = tab + s * 64 + f0;
    const float4 cr = *(const float4*)(t), sr = *(const float4*)(t + 16), cc = *(const float4*)(t + 32), sc = *(const float4*)(t + 48);
    const float crv[4] = {cr.x, cr.y, cr.z, cr.w}, srv[4] = {sr.x, sr.y, sr.z, sr.w};
    const float ccv[4] = {cc.x, cc.y, cc.z, cc.w}, scv[4] = {sc.x, sc.y, sc.z, sc.w};
#pragma unroll
    for (int j = 0; j < 4; ++j) {
      const float x1 = acc[0][mi][j], x2 = acc[1][mi][j], y1 = acc[2][mi][j], y2 = acc[3][mi][j];
      acc[0][mi][j] = x1 * crv[j] - x2 * srv[j]; acc[1][mi][j] = x1 * srv[j] + x2 * crv[j];
      acc[2][mi][j] = y1 * ccv[j] - y2 * scv[j]; acc[3][mi][j] = y1 * scv[j] + y2 * ccv[j];
    }
  }
}
DI void rms_T(f32x4 (&acc)[4][4], const float* w, int lane) {
  const int f0 = (lane >> 4) * 4;
  float4 wv[4];
#pragma unroll
  for (int ni = 0; ni < 4; ++ni) wv[ni] = *(const float4*)(w + ni * 16 + f0);
#pragma unroll
  for (int mi = 0; mi < 4; ++mi) {
    float ss = 0;
#pragma unroll
    for (int ni = 0; ni < 4; ++ni)
#pragma unroll
      for (int j = 0; j < 4; ++j) ss += acc[ni][mi][j] * acc[ni][mi][j];
    ss += __shfl_xor(ss, 16);
    ss += __shfl_xor(ss, 32);
    const float r = rsqrtf(ss * (1.0f / 64.0f) + EPS);
#pragma unroll
    for (int ni = 0; ni < 4; ++ni) {
      acc[ni][mi][0] *= r * wv[ni].x; acc[ni][mi][1] *= r * wv[ni].y;
      acc[ni][mi][2] *= r * wv[ni].z; acc[ni][mi][3] *= r * wv[ni].w;
    }
  }
}
DI void store_bf16_T(f32x4 (&acc)[4][4], u16* dst, size_t ld, int lane, float scale) {
  const int l15 = lane & 15, f0 = (lane >> 4) * 4;
#pragma unroll
  for (int mi = 0; mi < 4; ++mi)
#pragma unroll
    for (int ni = 0; ni < 4; ++ni) {
      uint2 o;
      o.x = pack2(acc[ni][mi][0] * scale, acc[ni][mi][1] * scale);
      o.y = pack2(acc[ni][mi][2] * scale, acc[ni][mi][3] * scale);
      *(uint2*)(dst + (size_t)(mi * 16 + l15) * ld + ni * 16 + f0) = o;
    }
}
DI void store_f32_T(f32x4 (&acc)[4][4], float* dst, size_t ld, int lane) {
  const int l15 = lane & 15, f0 = (lane >> 4) * 4;
#pragma unroll
  for (int mi = 0; mi < 4; ++mi)
#pragma unroll
    for (int ni = 0; ni < 4; ++ni) {
      float4 o = {acc[ni][mi][0], acc[ni][mi][1], acc[ni][mi][2], acc[ni][mi][3]};
      *(float4*)(dst + (size_t)(mi * 16 + l15) * ld + ni * 16 + f0) = o;
    }
}
DI void silu_tile(f32x4 (&acc)[4][4]) {
#pragma unroll
  for (int a = 0; a < 4; ++a)
#pragma unroll
    for (int b = 0; b < 4; ++b)
#pragma unroll
      for (int j = 0; j < 4; ++j) acc[a][b][j] = silu(acc[a][b][j]);
}
DI void stage_bf16_T(f32x4 (&acc)[4][4], unsigned char* stg, u16* dst, size_t ld, int lane, float scale) {
  const int l15 = lane & 15, g = lane >> 4;
#pragma unroll
  for (int mi = 0; mi < 4; ++mi)
#pragma unroll
    for (int ni = 0; ni < 4; ++ni) {
      uint2 o;
      o.x = pack2(acc[ni][mi][0] * scale, acc[ni][mi][1] * scale);
      o.y = pack2(acc[ni][mi][2] * scale, acc[ni][mi][3] * scale);
      *(uint2*)(stg + (mi * 16 + l15) * 144 + ni * 32 + g * 8) = o;
    }
  uint4 v[8];
#pragma unroll
  for (int i = 0; i < 8; ++i) {
    const int id = lane + 64 * i, row = id >> 3, c = id & 7;
    v[i] = *(const uint4*)(stg + row * 144 + c * 16);
  }
#pragma unroll
  for (int i = 0; i < 8; ++i) {
    const int id = lane + 64 * i, row = id >> 3, c = id & 7;
    st16_wt(dst + (size_t)row * ld + c * 8, v[i]);
  }
}
DI void stage_f32_half_T(f32x4 (&acc)[4][4], unsigned char* stg, int half, int lane) {
  const int l15 = lane & 15, g = lane >> 4;
#pragma unroll
  for (int m2 = 0; m2 < 2; ++m2)
#pragma unroll
    for (int ni = 0; ni < 4; ++ni) {
      const int mi = half * 2 + m2;
      float4 o = {acc[ni][mi][0], acc[ni][mi][1], acc[ni][mi][2], acc[ni][mi][3]};
      *(float4*)(stg + (m2 * 16 + l15) * 272 + (ni * 16 + g * 4) * 4) = o;
    }
}
DI void stage_f32_T(f32x4 (&acc)[4][4], unsigned char* stg, float* dst, size_t ld, int lane) {
#pragma unroll
  for (int half = 0; half < 2; ++half) {
    stage_f32_half_T(acc, stg, half, lane);
    float4 v[8];
#pragma unroll
    for (int i = 0; i < 8; ++i) {
      const int id = lane + 64 * i, row = id >> 4, c = id & 15;
      v[i] = *(const float4*)(stg + row * 272 + c * 16);
    }
#pragma unroll
    for (int i = 0; i < 8; ++i) {
      const int id = lane + 64 * i, row = id >> 4, c = id & 15;
      st16_wt(dst + (size_t)(half * 32 + row) * ld + c * 4, v[i]);
    }
  }
}
DI void store_f32_N(f32x4 (&acc)[4][4], float* dst, size_t ld, int lane) {
  const int c = lane & 15, rq = (lane >> 4) * 4;
#pragma unroll
  for (int mi = 0; mi < 4; ++mi)
#pragma unroll
    for (int j = 0; j < 4; ++j)
#pragma unroll
      for (int ni = 0; ni < 4; ++ni) dst[(size_t)(mi * 16 + rq + j) * ld + ni * 16 + c] = acc[mi][ni][j];
}
DI void store_tr_N(f32x4 (&acc)[4][4], u16* dst, size_t ld, int lane) {
  const int c = lane & 15, rq = (lane >> 4) * 4;
#pragma unroll
  for (int mi = 0; mi < 4; ++mi)
#pragma unroll
    for (int ni = 0; ni < 4; ++ni) {
      uint2 o;
      o.x = pack2(acc[mi][ni][0], acc[mi][ni][1]);
      o.y = pack2(acc[mi][ni][2], acc[mi][ni][3]);
      st8_wt(dst + (size_t)(ni * 16 + c) * ld + mi * 16 + rq, o);
    }
}
DI void store_k(const Params& p, f32x4 (&acc)[4][4], unsigned char* stg, int rbase, int lane, int nh, int hidx, size_t off_kc, size_t off_ks) {
  if (rbase < M_CTX) {
    const int b = rbase >> 8, s0 = rbase & 255;
    stage_bf16_T(acc, stg, (u16*)(p.ws + off_kc) + ((size_t)(b * nh + hidx) * 256 + s0) * 64, 64, lane, 1.0f);
  } else {
    const int r = rbase - M_CTX, b = r >> 10, s0 = r & 1023;
    stage_bf16_T(acc, stg, (u16*)(p.ws + off_ks) + ((size_t)(b * nh + hidx) * 1280 + s0) * 64, 64, lane, 1.0f);
  }
}
DI void store_tr_tiled_N(f32x4 (&acc)[4][4], u16* head_base, int dv0, int s0, int lane) {
  const int c = lane & 15, rq = (lane >> 4) * 4;
#pragma unroll
  for (int mi = 0; mi < 4; ++mi)
#pragma unroll
    for (int ni = 0; ni < 4; ++ni) {
      uint2 o;
      o.x = pack2(acc[mi][ni][0], acc[mi][ni][1]);
      o.y = pack2(acc[mi][ni][2], acc[mi][ni][3]);
      const int t = s0 + mi * 16 + rq;
      st8_wt(head_base + ((size_t)(t >> 5) * 128 + dv0 + ni * 16 + c) * 32 + (t & 31), o);
    }
}
DI void store_v(const Params& p, f32x4 (&acc)[4][4], int rbase, int lane, int nh, int hidx, int dvh, int dv0, size_t off_vc, size_t off_vs) {
  if (rbase < M_CTX) {
    const int b = rbase >> 8, s0 = rbase & 255;
    if (dvh == 128) store_tr_tiled_N(acc, (u16*)(p.ws + off_vc) + (size_t)(b * nh + hidx) * 128 * 256, dv0, s0, lane);
    else store_tr_N(acc, (u16*)(p.ws + off_vc) + ((size_t)(b * nh + hidx) * dvh + dv0) * 256 + s0, 256, lane);
  } else {
    const int r = rbase - M_CTX, b = r >> 10, s0 = r & 1023;
    if (dvh == 128) store_tr_tiled_N(acc, (u16*)(p.ws + off_vs) + (size_t)(b * nh + hidx) * 128 * 1280, dv0, s0, lane);
    else store_tr_N(acc, (u16*)(p.ws + off_vs) + ((size_t)(b * nh + hidx) * dvh + dv0) * 1280 + s0, 1280, lane);
  }
}

enum { EPI_IN0 = 0, EPI_OUT0 = 1, EPI_IN1 = 2, EPI_OUT1 = 3 };

template <int EPI>
DI bool is_v_tile(int n0) {
  if (EPI == EPI_IN0) return n0 == 640 || n0 == 1920;
  if (EPI == EPI_IN1) return n0 >= 2048 && n0 < 3072;
  return false;
}

template <int EPI>
DI void epilogue(const Params& p, f32x4 (&acc)[4][4], unsigned char* stg, int rbase, int cb, int lane) {
  const bool smp = rbase >= M_CTX;
  u16* Q = (u16*)(p.ws + OFF_Q);
  u16* G = (u16*)(p.ws + OFF_G);
  if (EPI == EPI_IN0) {
    if (cb < 512) {
      rms_T(acc, p.in[I_QNA], lane);
      if (smp) rope_T(p, acc, rbase, lane);
      stage_bf16_T(acc, stg, Q + (size_t)rbase * 1024 + cb, 1024, lane, QSCALE);
    } else if (cb < 640) {
      const int kvh = (cb - 512) >> 6;
      rms_T(acc, p.in[I_KNA], lane);
      if (!smp) stage_f32_T(acc, stg, p.out + O_AK + (size_t)rbase * 128 + kvh * 64, 128, lane);
      else rope_T(p, acc, rbase, lane);
      store_k(p, acc, stg, rbase, lane, 2, kvh, OFF_KCA, OFF_KSA);
    } else if (cb < 768) {
      const int kvh = (cb - 640) >> 6;
      if (!smp) store_f32_N(acc, p.out + O_AV + (size_t)rbase * 128 + kvh * 64, 128, lane);
      store_v(p, acc, rbase, lane, 2, kvh, 64, 0, OFF_VCA, OFF_VSA);
    } else if (cb < 1280) {
      silu_tile(acc);
      stage_bf16_T(acc, stg, G + (size_t)rbase * 1024 + (cb - 768), 1024, lane, 1.0f);
    } else if (cb < 1792) {
      if (smp) rope_T(p, acc, rbase, lane);
      stage_bf16_T(acc, stg, Q + (size_t)rbase * 1024 + 512 + (cb - 1280), 1024, lane, QSCALE);
    } else if (cb < 1920) {
      const int kvh = (cb - 1792) >> 6;
      if (!smp) stage_f32_T(acc, stg, p.out + O_BK + (size_t)rbase * 128 + kvh * 64, 128, lane);
      else rope_T(p, acc, rbase, lane);
      store_k(p, acc, stg, rbase, lane, 2, kvh, OFF_KCB, OFF_KSB);
    } else if (cb < 2048) {
      const int kvh = (cb - 1920) >> 6;
      if (!smp) store_f32_N(acc, p.out + O_BV + (size_t)rbase * 128 + kvh * 64, 128, lane);
      store_v(p, acc, rbase, lane, 2, kvh, 64, 0, OFF_VCB, OFF_VSB);
    } else {
      silu_tile(acc);
      stage_bf16_T(acc, stg, G + (size_t)rbase * 1024 + 512 + (cb - 2048), 1024, lane, 1.0f);
    }
  } else if (EPI == EPI_IN1) {
    if (cb < 1024) {
      if (smp) rope_T(p, acc, rbase, lane);
      stage_bf16_T(acc, stg, Q + (size_t)rbase * 1024 + cb, 1024, lane, QSCALE);
    } else if (cb < 2048) {
      const int hh = (cb - 1024) >> 6;
      if (!smp) stage_f32_T(acc, stg, p.out + O_CK + (size_t)rbase * 1024 + (cb - 1024), 1024, lane);
      else rope_T(p, acc, rbase, lane);
      store_k(p, acc, stg, rbase, lane, 16, hh, OFF_KCC, OFF_KSC);
    } else if (cb < 3072) {
      const int head = (cb - 2048) >> 7, dv0 = (cb - 2048) & 127;
      if (!smp) store_f32_N(acc, p.out + O_CV + (size_t)rbase * 1024 + (cb - 2048), 1024, lane);
      store_v(p, acc, rbase, lane, 8, head, 128, dv0, OFF_VCC, OFF_VSC);
    } else {
      silu_tile(acc);
      stage_bf16_T(acc, stg, G + (size_t)rbase * 1024 + (cb - 3072), 1024, lane, 1.0f);
    }
  } else {
    const int l = (EPI == EPI_OUT0) ? 0 : 1;
    const float* gate = (const float*)(p.ws + OFF_MOD) + (l * 3 + modvec(rbase)) * 3072 + 2048 + cb;
    const float* xres = ((EPI == EPI_OUT0) ? xrow(p, rbase) : (const float*)(p.ws + OFF_X1) + (size_t)rbase * 1024) + cb;
    float* R = (float*)(p.ws + OFF_R) + (size_t)rbase * 1024 + cb;
    const int c = lane & 15;
    const float4 gv = *(const float4*)(gate + c * 4);
#pragma unroll
    for (int half = 0; half < 2; ++half) {
      stage_f32_half_T(acc, stg, half, lane);
#pragma unroll
      for (int i = 0; i < 8; ++i) {
        const int row = (lane >> 4) + 4 * i;
        const float4 a = *(const float4*)(stg + row * 272 + c * 16);
        const size_t o = (size_t)(half * 32 + row) * 1024 + c * 4;
        const float4 x = *(const float4*)(xres + o);
        float4 r;
        r.x = ALPHA * x.x + gv.x * a.x; r.y = ALPHA * x.y + gv.y * a.y;
        r.z = ALPHA * x.z + gv.z * a.z; r.w = ALPHA * x.w + gv.w * a.w;
        st16_wt(R + o, r);
      }
    }
  }
}

DI void gemm_stage(const u16* ag, const u16* bg, u16* sa, u16* sb, int tid, int k0) {
#pragma unroll
  for (int i = 0; i < 4; ++i) {
    const int id = tid + 256 * i;
    const int row = id >> 3, c = (id & 7) ^ ((row >> 1) & 7);
    __builtin_amdgcn_global_load_lds((const unsigned*)(ag + (size_t)row * 1024 + k0 + c * 8), (unsigned*)(sa + id * 8), 16, 0, 0);
    __builtin_amdgcn_global_load_lds((const unsigned*)(bg + (size_t)row * 1024 + k0 + c * 8), (unsigned*)(sb + id * 8), 16, 0, 0);
  }
}

template <bool SWAP>
DI void gemm_mainloop(const u16* ag, const u16* bg, u16* sA, u16* sB, int tid, int wm, int wn, f32x4 (&acc)[4][4]) {
  const int lane = tid & 63;
#pragma unroll
  for (int a = 0; a < 4; ++a)
#pragma unroll
    for (int b = 0; b < 4; ++b) acc[a][b] = f32x4{0.f, 0.f, 0.f, 0.f};
  gemm_stage(ag, bg, sA, sB, tid, 0);
  __syncthreads();
  const int ra = wm * 64 + (lane & 15), rb = wn * 64 + (lane & 15);
  const int swa = (ra >> 1) & 7, swb = (rb >> 1) & 7;
  const int q = lane >> 4;
#pragma unroll 2
  for (int kt = 0; kt < 16; ++kt) {
    const int cur = kt & 1;
    if (kt + 1 < 16) gemm_stage(ag, bg, sA + (cur ^ 1) * 8192, sB + (cur ^ 1) * 8192, tid, (kt + 1) * 64);
    const u16* a_s = sA + cur * 8192 + ra * 64;
    const u16* b_s = sB + cur * 8192 + rb * 64;
#pragma unroll
    for (int ks = 0; ks < 2; ++ks) {
      bf16x8 af[4], bfr[4];
#pragma unroll
      for (int mi = 0; mi < 4; ++mi) af[mi] = *(const bf16x8*)(a_s + mi * 16 * 64 + (((ks * 4 + q) ^ swa) * 8));
#pragma unroll
      for (int ni = 0; ni < 4; ++ni) bfr[ni] = *(const bf16x8*)(b_s + ni * 16 * 64 + (((ks * 4 + q) ^ swb) * 8));
#pragma unroll
      for (int a = 0; a < 4; ++a)
#pragma unroll
        for (int b = 0; b < 4; ++b) {
          if (SWAP) acc[a][b] = MFMA16(bfr[a], af[b], acc[a][b]);
          else acc[a][b] = MFMA16(af[a], bfr[b], acc[a][b]);
        }
    }
    __syncthreads();
  }
}

template <int EPI>
DI void gemm_phase(const Params& p, unsigned char* smem, const u16* A, const u16* Wt, int N, bool do_epi = true, bool fuse_ln = false) {
  const int tid = threadIdx.x, lane = tid & 63, wave = tid >> 6;
  const int wm = wave >> 1, wn = wave & 1;
  const int NT = N >> 7;
  const int ntiles = 48 * NT;
  u16* sA = (u16*)smem;
  u16* sB = sA + 2 * 8192;
#if GEMM_SKEW
  if (blockIdx.x >= (gridDim.x >> 1)) { for (int i = 0; i < GEMM_SKEW; ++i) __builtin_amdgcn_s_sleep(127); }
#endif
  const bool xcd_map = (gridDim.x & 7) == 0;
  const int nslot = xcd_map ? (gridDim.x >> 3) : gridDim.x;
  const int slot = xcd_map ? (blockIdx.x >> 3) : blockIdx.x;
  const int nloc = xcd_map ? 6 * NT : ntiles;
  for (int j = slot; j < nloc; j += nslot) {
    int tm, tn;
    if (xcd_map) { tn = j / 6; tm = (blockIdx.x & 7) * 6 + (j - tn * 6); }
    else { tm = j / NT; tn = j - tm * NT; }
    const int m0 = tm * 128, n0 = tn * 128;
    f32x4 acc[4][4];
    const u16* ag = A + (size_t)m0 * 1024;
    const u16* bg = Wt + (size_t)n0 * 1024;
    if (is_v_tile<EPI>(n0)) gemm_mainloop<false>(ag, bg, sA, sB, tid, wm, wn, acc);
    else gemm_mainloop<true>(ag, bg, sA, sB, tid, wm, wn, acc);
    int lane_e = lane;
    asm volatile("" : "+v"(lane_e));
    if (do_epi && fuse_ln && (EPI == EPI_OUT0 || EPI == EPI_OUT1))
      epilogue_ln<(EPI == EPI_OUT1) ? EPI_OUT1 : EPI_OUT0>(p, acc, smem + wave * 9216, m0 + wm * 64, n0 + wn * 64, lane_e, tm, tn * 2 + wn);
    else if (do_epi) epilogue<EPI>(p, acc, smem + wave * 9216, m0 + wm * 64, n0 + wn * 64, lane_e);
    else if (p.ph_hi > 1000) {
      float s = 0;
      for (int a = 0; a < 4; ++a) for (int b = 0; b < 4; ++b) s += acc[a][b][0] + acc[a][b][1] + acc[a][b][2] + acc[a][b][3];
      p.out[lane_e] = s;
    }
    __syncthreads();
  }
}

DI unsigned band_ld(unsigned* p) { return __hip_atomic_load(p, __ATOMIC_RELAXED, __HIP_MEMORY_SCOPE_AGENT); }
template <int EPI>
DI void epilogue_ln(const Params& p, f32x4 (&acc)[4][4], unsigned char* stg, int rbase, int cb, int lane, int tm, int slot16) {
  constexpr int l = (EPI == EPI_OUT0) ? 0 : 1;
  const int l15 = lane & 15, g = lane >> 4, f0 = g * 4;
  const float* mod = (const float*)(p.ws + OFF_MOD);
  const int mv = modvec(rbase);
  {
    const float* gate = mod + (l * 3 + mv) * 3072 + 2048 + cb + f0;
    const float* xres = ((EPI == EPI_OUT0) ? xrow(p, rbase) : (const float*)(p.ws + OFF_X1) + (size_t)rbase * 1024) + cb + f0;
    float4 gv[4];
#pragma unroll
    for (int ni = 0; ni < 4; ++ni) gv[ni] = *(const float4*)(gate + ni * 16);
#pragma unroll
    for (int mi = 0; mi < 4; ++mi)
#pragma unroll
      for (int ni = 0; ni < 4; ++ni) {
        const float4 x = *(const float4*)(xres + (size_t)(mi * 16 + l15) * 1024 + ni * 16);
        acc[ni][mi][0] = ALPHA * x.x + gv[ni].x * acc[ni][mi][0]; acc[ni][mi][1] = ALPHA * x.y + gv[ni].y * acc[ni][mi][1];
        acc[ni][mi][2] = ALPHA * x.z + gv[ni].z * acc[ni][mi][2]; acc[ni][mi][3] = ALPHA * x.w + gv[ni].w * acc[ni][mi][3];
      }
  }
  unsigned long long* part = (unsigned long long*)(p.ws + OFF_PART);
#pragma unroll
  for (int mi = 0; mi < 4; ++mi) {
    float s = 0.f, q = 0.f;
#pragma unroll
    for (int ni = 0; ni < 4; ++ni)
#pragma unroll
      for (int j = 0; j < 4; ++j) { s += acc[ni][mi][j]; q += acc[ni][mi][j] * acc[ni][mi][j]; }
    s += __shfl_xor(s, 16); s += __shfl_xor(s, 32);
    q += __shfl_xor(q, 16); q += __shfl_xor(q, 32);
    if (g == 0) st8_wt(part + (size_t)(rbase + mi * 16 + l15) * 16 + slot16, uint2{__float_as_uint(s), __float_as_uint(q)});
  }
  asm volatile("s_waitcnt vmcnt(0)" ::: "memory");
  __syncthreads();
  if (threadIdx.x == 0) {
    unsigned* bc = (unsigned*)(p.ws + OFF_BAR) + BANDCNT_WORD + l * 48 + tm;
    __hip_atomic_fetch_add(bc, 1u, __ATOMIC_RELAXED, __HIP_MEMORY_SCOPE_AGENT);
    unsigned spins = 0;
    while (band_ld(bc) < 8u && ++spins < (1u << 22)) __builtin_amdgcn_s_sleep(1);
    __builtin_amdgcn_fence(__ATOMIC_ACQUIRE, "agent");
    asm volatile("s_waitcnt vmcnt(0)" ::: "memory");
  }
  __syncthreads();
  const float* lg = p.in[I_LNG] + l * 1024 + cb + f0;
  const float* lb = p.in[I_LNB] + l * 1024 + cb + f0;
  float4 gam[4], bet[4];
#pragma unroll
  for (int ni = 0; ni < 4; ++ni) { gam[ni] = *(const float4*)(lg + ni * 16); bet[ni] = *(const float4*)(lb + ni * 16); }
#pragma unroll
  for (int mi = 0; mi < 4; ++mi) {
    unsigned long long* pr = part + (size_t)(rbase + mi * 16 + l15) * 16 + g * 4;
    float s = 0.f, q = 0.f;
#pragma unroll
    for (int k = 0; k < 4; ++k) {
      const unsigned long long v = __hip_atomic_load(pr + k, __ATOMIC_RELAXED, __HIP_MEMORY_SCOPE_AGENT);
      s += __uint_as_float((unsigned)v); q += __uint_as_float((unsigned)(v >> 32));
    }
    s += __shfl_xor(s, 16); s += __shfl_xor(s, 32);
    q += __shfl_xor(q, 16); q += __shfl_xor(q, 32);
    const float mean = s * (1.0f / 1024.0f);
    const float var = fmaxf(q * (1.0f / 1024.0f) - mean * mean, 0.f);
    const float rstd = rsqrtf(var + EPS);
#pragma unroll
    for (int ni = 0; ni < 4; ++ni) {
      acc[ni][mi][0] = (acc[ni][mi][0] - mean) * rstd * gam[ni].x + bet[ni].x; acc[ni][mi][1] = (acc[ni][mi][1] - mean) * rstd * gam[ni].y + bet[ni].y;
      acc[ni][mi][2] = (acc[ni][mi][2] - mean) * rstd * gam[ni].z + bet[ni].z; acc[ni][mi][3] = (acc[ni][mi][3] - mean) * rstd * gam[ni].w + bet[ni].w;
    }
  }
  if (EPI == EPI_OUT0) {
    stage_f32_T(acc, stg, (float*)(p.ws + OFF_X1) + (size_t)rbase * 1024 + cb, 1024, lane);
    const float* m1 = mod + (3 + mv) * 3072 + cb + f0;
#pragma unroll
    for (int ni = 0; ni < 4; ++ni) {
      const float4 sh = *(const float4*)(m1 + ni * 16), sc = *(const float4*)(m1 + 1024 + ni * 16);
#pragma unroll
      for (int mi = 0; mi < 4; ++mi) {
        acc[ni][mi][0] = acc[ni][mi][0] * (1.f + sc.x) + sh.x; acc[ni][mi][1] = acc[ni][mi][1] * (1.f + sc.y) + sh.y;
        acc[ni][mi][2] = acc[ni][mi][2] * (1.f + sc.z) + sh.z; acc[ni][mi][3] = acc[ni][mi][3] * (1.f + sc.w) + sh.w;
      }
    }
    stage_bf16_T(acc, stg, (u16*)(p.ws + OFF_H) + (size_t)rbase * 1024 + cb, 1024, lane, 1.0f);
  } else {
    stage_f32_T(acc, stg, p.out + (size_t)rbase * 1024 + cb, 1024, lane);
  }
}

DI void glds16_asm(const void* gsrc, unsigned lds_dst) {
  unsigned keep;
  asm volatile("s_mov_b32 %0, m0\n\ts_mov_b32 m0, %2\n\ts_nop 0\n\tglobal_load_lds_dwordx4 %1, off\n\ts_mov_b32 m0, %0"
               : "=&s"(keep) : "v"(gsrc), "s"(lds_dst) : "memory");
}
template <int LAYER>
DI void attn_issue(unsigned st, const u16* Kg0, const u16* Kg1, const u16* Vg, int vs, int key0, int tid) {
  const unsigned wb = __builtin_amdgcn_readfirstlane(st + (unsigned)(tid >> 6) * 1024u);
  if (LAYER == 0) {
#pragma unroll
    for (int i = 0; i < 2; ++i) {
      const int id = tid + 256 * i, row = id >> 3, c = (id & 7) ^ ((row >> 1) & 7);
      glds16_asm(Kg0 + (size_t)(key0 + row) * 64 + c * 8, wb + i * 4096);
      glds16_asm(Vg + (size_t)row * vs + key0 + c * 8, wb + 8192 + i * 4096);
    }
  } else {
    {
      const int id = tid, row = id >> 3, c = (id & 7) ^ ((row >> 1) & 7);
      glds16_asm(Kg0 + (size_t)(key0 + row) * 64 + c * 8, wb);
      glds16_asm(Kg1 + (size_t)(key0 + row) * 64 + c * 8, wb + 4096);
    }
#pragma unroll
    for (int i = 0; i < 2; ++i) {
      const int id = tid + 256 * i, row = id >> 2, c = (id & 3) ^ ((row >> 2) & 3);
      glds16_asm(Vg + (size_t)(key0 >> 5) * 4096 + row * 32 + c * 8, wb + 8192 + i * 4096);
    }
  }
}

template <int LAYER>
DI void flash_lds(const u16* Qp, unsigned char* ring, const u16* Kg0, const u16* Kg1, const u16* Vg, int vs, int kmap,
                  int tb1, int te1, int tb2, int te2, bool use_mask, int qpos0, float m_init, float l_init,
                  f32x16 (&O)[LAYER ? 4 : 2], float& l_out) {
  constexpr int DV = LAYER ? 128 : 64;
  constexpr int NSUB = LAYER ? 1 : 2;
  constexpr int KS = 32 * NSUB;
  const int tid = threadIdx.x, lane = tid & 63, r = lane & 31, h = lane >> 5;
  bf16x8 qf[4];
#pragma unroll
  for (int ks = 0; ks < 4; ++ks) qf[ks] = *(const bf16x8*)(Qp + (size_t)r * 1024 + ks * 16 + 8 * h);
#pragma unroll
  for (int d = 0; d < DV / 32; ++d)
#pragma unroll
    for (int i = 0; i < 16; ++i) O[d][i] = 0.f;
  float m = m_init;
  const f32x16 zero16 = {0.f, 0.f, 0.f, 0.f, 0.f, 0.f, 0.f, 0.f, 0.f, 0.f, 0.f, 0.f, 0.f, 0.f, 0.f, 0.f};
  f32x16 L = zero16;
  L[0] = l_init;
  const short one_bf = (r == 0 || r == 4) ? (short)0x3F80 : (short)0;
  const bf16x8 onesf = {one_bf, one_bf, one_bf, one_bf, one_bf, one_bf, one_bf, one_bf};
  const int pr = (r & 0x13) | ((r & 4) << 1) | ((r & 8) >> 1);
  const int n1 = te1 - tb1, ntot = n1 + (te2 - tb2);
  const int koff = (LAYER ? kmap * 4096 : 0) + pr * 128;
  const int ksw = (pr >> 1) & 7;
  const int voff = 8192 + (LAYER ? r * 64 : r * 128);
  const int vsw = LAYER ? ((r >> 2) & 3) : ((r >> 1) & 7);
  asm volatile("" : "+v"(qf[0]), "+v"(qf[1]), "+v"(qf[2]), "+v"(qf[3]));
  asm volatile("s_waitcnt vmcnt(0)" ::: "memory");
#define TKEY(it_) (((it_) < n1 ? tb1 + (it_) : tb2 + ((it_) - n1)) * KS)
  const unsigned ring_lds = (unsigned)(size_t)ring;
  attn_issue<LAYER>(ring_lds, Kg0, Kg1, Vg, vs, TKEY(0), tid);
  if (ntot > 1) attn_issue<LAYER>(ring_lds + 16384, Kg0, Kg1, Vg, vs, TKEY(1), tid);
  if (ntot > 2) attn_issue<LAYER>(ring_lds + 32768, Kg0, Kg1, Vg, vs, TKEY(2), tid);
  for (int it = 0; it < ntot; ++it) {
    const int rem = ntot - 1 - it;
    if (rem >= 2) asm volatile("s_waitcnt vmcnt(8)" ::: "memory");
    else if (rem == 1) asm volatile("s_waitcnt vmcnt(4)" ::: "memory");
    else asm volatile("s_waitcnt vmcnt(0)" ::: "memory");
    __builtin_amdgcn_s_barrier();
    if (it + 3 < ntot) attn_issue<LAYER>(ring_lds + ((it + 3) & 3) * 16384, Kg0, Kg1, Vg, vs, TKEY(it + 3), tid);
    const unsigned char* st = ring + (it & 3) * 16384;
    const int key0 = TKEY(it);
    f32x16 S[NSUB];
#pragma unroll
    for (int u = 0; u < NSUB; ++u) {
      bf16x8 kf[4];
#pragma unroll
      for (int ks = 0; ks < 4; ++ks) kf[ks] = *(const bf16x8*)(st + koff + u * 4096 + (((ks * 2 + h) ^ ksw) * 16));
      S[u] = MFMA32(kf[0], qf[0], zero16);
#pragma unroll
      for (int ks = 1; ks < 4; ++ks) S[u] = MFMA32(kf[ks], qf[ks], S[u]);
    }
    if (use_mask && it < n1 && !(key0 >= qpos0 + 31 - 128 && key0 + KS - 1 <= qpos0 + 128)) {
      const int q = qpos0 + r;
#pragma unroll
      for (int u = 0; u < NSUB; ++u)
#pragma unroll
        for (int i = 0; i < 16; ++i) {
          const int key = key0 + 32 * u + (i & 3) + 4 * ((i >> 2) & 1) + 8 * h + 16 * (i >> 3);
          const int dlt = key - q;
          S[u][i] = (dlt <= 128 && dlt >= -128) ? S[u][i] : -1e30f;
        }
    }
    float mx = S[0][0];
#pragma unroll
    for (int u = 0; u < NSUB; ++u)
#pragma unroll
      for (int i = 0; i < 16; ++i) mx = fmaxf(mx, S[u][i]);
    {
      const unsigned mu = __float_as_uint(mx);
      const auto sw = __builtin_amdgcn_permlane32_swap(mu, mu, false, false);
      mx = fmaxf(__uint_as_float(sw[0]), __uint_as_float(sw[1]));
    }
    const float mn = fmaxf(m, mx);
    if (__builtin_amdgcn_ballot_w64(mn != m) != 0) {
      const float alpha = exp2f_fast(m - mn);
#pragma unroll
      for (int d = 0; d < DV / 32; ++d)
#pragma unroll
        for (int i = 0; i < 16; ++i) O[d][i] *= alpha;
      L[0] *= alpha;
    }
    m = mn;
    const float nm = -mn;
#pragma unroll
    for (int u = 0; u < NSUB; ++u) {
      S[u] = S[u] + nm;
#pragma unroll
      for (int i = 0; i < 16; ++i) S[u][i] = exp2f_fast(S[u][i]);
    }
#pragma unroll
    for (int u = 0; u < NSUB; ++u) {
      bf16x8 pf[2];
#pragma unroll
      for (int s = 0; s < 2; ++s) {
        uint4 w;
        w.x = pack2(S[u][8 * s + 0], S[u][8 * s + 1]); w.y = pack2(S[u][8 * s + 2], S[u][8 * s + 3]);
        w.z = pack2(S[u][8 * s + 4], S[u][8 * s + 5]); w.w = pack2(S[u][8 * s + 6], S[u][8 * s + 7]);
        pf[s] = __builtin_bit_cast(bf16x8, w);
      }
#pragma unroll
      for (int s = 0; s < 2; ++s) L = MFMA32(onesf, pf[s], L);
#pragma unroll
      for (int d = 0; d < DV / 32; ++d)
#pragma unroll
        for (int s = 0; s < 2; ++s) {
          const bf16x8 vf = *(const bf16x8*)(st + voff + d * 32 * (LAYER ? 64 : 128) + (((4 * u + 2 * s + h) ^ vsw) * 16));
          O[d] = MFMA32(vf, pf[s], O[d]);
        }
    }
  }
#undef TKEY
  l_out = L[0];
}

DI void attn0_phase(const Params& p, unsigned char* smem, int cidx) {
  const int tid = threadIdx.x, lane = tid & 63, wave = tid >> 6;
  int* cnt = (int*)(p.ws + OFF_CNT) + cidx;
  int* s_item = (int*)(smem + 65536);
  const u16* Q = (const u16*)(p.ws + OFF_Q);
  const u16* G = (const u16*)(p.ws + OFF_G);
  u16* AO = (u16*)(p.ws + OFF_AO);
  for (int round = 0;; ++round) {
    if (tid == 0) *s_item = round == 0 ? (int)blockIdx.x : (int)gridDim.x + atomicAdd(cnt, 1);
    __syncthreads();
    const int item = *s_item;
    __syncthreads();
    if (item >= 768) break;
    int br, row0, head, vs, tb1, te1, tb2 = 0, te2 = 0, qpos0 = 0;
    bool use_mask = false;
    const u16 *Kp, *Vp;
    if (item < 256) {
      br = item >> 7;
      const int r = item & 127, b = r >> 6, kvh = (r >> 5) & 1, qb = r & 31;
      head = kvh * 4 + wave;
      row0 = M_CTX + b * 1024 + qb * 32;
      Kp = (const u16*)(p.ws + (br ? OFF_KSB : OFF_KSA)) + (size_t)(b * 2 + kvh) * 1280 * 64;
      Vp = (const u16*)(p.ws + (br ? OFF_VSB : OFF_VSA)) + (size_t)(b * 2 + kvh) * 64 * 1280;
      vs = 1280;
      if (br == 0) { tb1 = 0; te1 = 20; }
      else {
        const int q0 = qb * 32;
        tb1 = q0 >= 128 ? (q0 - 128) >> 6 : 0;
        te1 = ((q0 + 159) >> 6) + 1; if (te1 > 16) te1 = 16;
        tb2 = 16; te2 = 20; use_mask = true; qpos0 = q0;
      }
    } else {
      int r = item - 256;
      br = r >> 8; r &= 255;
      const int b = r >> 4, kvh = (r >> 3) & 1, qb = r & 7;
      head = kvh * 4 + wave;
      row0 = b * 256 + qb * 32;
      Kp = (const u16*)(p.ws + (br ? OFF_KCB : OFF_KCA)) + (size_t)(b * 2 + kvh) * 256 * 64;
      Vp = (const u16*)(p.ws + (br ? OFF_VCB : OFF_VCA)) + (size_t)(b * 2 + kvh) * 64 * 256;
      vs = 256; tb1 = 0; te1 = 4;
    }
    const float m_init = br ? p.in[I_SINK][head] * LOG2E : -1e30f;
    const float l_init = br ? 1.0f : 0.0f;
    const int col0 = br * 512 + head * 64;
    f32x16 O[2];
    float l;
    flash_lds<0>(Q + (size_t)row0 * 1024 + col0, smem, Kp, Kp, Vp, vs, 0, tb1, te1, tb2, te2, use_mask, qpos0, m_init, l_init, O, l);
    const float inv = 1.0f / l;
    const int row = row0 + (lane & 31), h = lane >> 5;
#pragma unroll
    for (int d = 0; d < 2; ++d)
#pragma unroll
      for (int g = 0; g < 4; ++g) {
        const size_t o = (size_t)row * 1024 + col0 + d * 32 + 8 * g + 4 * h;
        const uint2 gv = *(const uint2*)(G + o);
        uint2 ov;
        ov.x = pack2(O[d][4 * g + 0] * inv * bflo(gv.x), O[d][4 * g + 1] * inv * bfhi(gv.x));
        ov.y = pack2(O[d][4 * g + 2] * inv * bflo(gv.y), O[d][4 * g + 3] * inv * bfhi(gv.y));
        st8_wt(AO + o, ov);
      }
  }
}

DI void attn1_phase(const Params& p, unsigned char* smem, int cidx) {
  const int tid = threadIdx.x, lane = tid & 63, wave = tid >> 6;
  int* cnt = (int*)(p.ws + OFF_CNT) + cidx;
  int* s_item = (int*)(smem + 65536);
  const u16* Q = (const u16*)(p.ws + OFF_Q);
  const u16* G = (const u16*)(p.ws + OFF_G);
  u16* AO = (u16*)(p.ws + OFF_AO);
  float* xch = (float*)smem;
  float lam;
  {
    const float a = p.in[I_LQ1][lane] * p.in[I_LK1][lane];
    const float b = p.in[I_LQ2][lane] * p.in[I_LK2][lane];
    lam = __expf(wave_sum(a)) - __expf(wave_sum(b)) + LAM_INIT;
  }
  const int map = wave & 1, qsub = wave >> 1;
  for (int round = 0;; ++round) {
    if (tid == 0) *s_item = round == 0 ? (int)blockIdx.x : (int)gridDim.x + atomicAdd(cnt, 1);
    __syncthreads();
    const int item = *s_item;
    __syncthreads();
    if (item >= 768) break;
    int row0, head, vs, te1;
    const u16 *Kp, *Vp;
    if (item < 256) {
      const int b = item >> 7, hd = (item >> 4) & 7, qb = item & 15;
      head = hd;
      row0 = M_CTX + b * 1024 + qb * 64 + qsub * 32;
      Kp = (const u16*)(p.ws + OFF_KSC) + (size_t)(b * 16 + hd * 2) * 1280 * 64;
      Vp = (const u16*)(p.ws + OFF_VSC) + (size_t)(b * 8 + hd) * 128 * 1280;
      vs = 1280; te1 = 40;
    } else {
      const int r = item - 256, b = r >> 5, hd = (r >> 2) & 7, qb = r & 3;
      head = hd;
      row0 = b * 256 + qb * 64 + qsub * 32;
      Kp = (const u16*)(p.ws + OFF_KCC) + (size_t)(b * 16 + hd * 2) * 256 * 64;
      Vp = (const u16*)(p.ws + OFF_VCC) + (size_t)(b * 8 + hd) * 128 * 256;
      vs = 256; te1 = 8;
    }
    f32x16 O[4];
    float l;
    flash_lds<1>(Q + (size_t)row0 * 1024 + (head * 2 + map) * 64, smem, Kp, Kp + (size_t)vs * 64, Vp, vs, map,
                 0, te1, 0, 0, false, 0, -1e30f, 0.0f, O, l);
    const float inv = 1.0f / l;
    __syncthreads();
    if (map == 1) {
#pragma unroll
      for (int d = 0; d < 4; ++d)
#pragma unroll
        for (int i = 0; i < 16; ++i) xch[(qsub * 64 + d * 16 + i) * 64 + lane] = O[d][i] * inv;
    }
    __syncthreads();
    if (map == 0) {
      float ss = 0.f;
#pragma unroll
      for (int d = 0; d < 4; ++d)
#pragma unroll
        for (int i = 0; i < 16; ++i) {
          const float o = O[d][i] * inv - lam * xch[(qsub * 64 + d * 16 + i) * 64 + lane];
          O[d][i] = o;
          ss += o * o;
        }
      ss += __shfl_xor(ss, 32);
      const float rr = rsqrtf(ss * (1.0f / 128.0f) + EPS) * (1.0f - LAM_INIT);
      const int row = row0 + (lane & 31), h = lane >> 5;
      const float* sw = p.in[I_SUBLN];
#pragma unroll
      for (int d = 0; d < 4; ++d)
#pragma unroll
        for (int g = 0; g < 4; ++g) {
          const int dv = d * 32 + 8 * g + 4 * h;
          const size_t o = (size_t)row * 1024 + head * 128 + dv;
          const uint2 gv = *(const uint2*)(G + o);
          const float4 w4 = *(const float4*)(sw + dv);
          uint2 ov;
          ov.x = pack2(O[d][4 * g + 0] * rr * w4.x * bflo(gv.x), O[d][4 * g + 1] * rr * w4.y * bfhi(gv.x));
          ov.y = pack2(O[d][4 * g + 2] * rr * w4.z * bflo(gv.y), O[d][4 * g + 3] * rr * w4.w * bfhi(gv.y));
          st8_wt(AO + o, ov);
        }
    }
  }
}

DI unsigned bar_ld(unsigned* p) { return __hip_atomic_load(p, __ATOMIC_RELAXED, __HIP_MEMORY_SCOPE_AGENT); }
DI unsigned bar_add(unsigned* p, unsigned v) { return __hip_atomic_fetch_add(p, v, __ATOMIC_RELAXED, __HIP_MEMORY_SCOPE_AGENT); }
DI void grid_bar(unsigned* bar, unsigned& epoch) {
  asm volatile("s_waitcnt vmcnt(0)" ::: "memory");
  __syncthreads();
  if (threadIdx.x == 0) {
    epoch += 1;
    __builtin_amdgcn_fence(__ATOMIC_RELEASE, "agent");
    asm volatile("s_waitcnt vmcnt(0)" ::: "memory");
    const unsigned ng = gridDim.x < 8 ? gridDim.x : 8;
    const unsigned grp = blockIdx.x % ng;
    const unsigned nloc = (gridDim.x - grp + ng - 1) / ng;
    const unsigned old = bar_add(&bar[64 * (1 + grp)], 1u);
    if (old + 1u == epoch * nloc) {
      const unsigned o2 = bar_add(&bar[0], 1u);
      if (o2 + 1u == epoch * ng) __hip_atomic_store(&bar[64 * 9], epoch, __ATOMIC_RELAXED, __HIP_MEMORY_SCOPE_AGENT);
    }
    while (bar_ld(&bar[64 * 9]) < epoch) __builtin_amdgcn_s_sleep(1);
    __builtin_amdgcn_fence(__ATOMIC_ACQUIRE, "agent");
    asm volatile("s_waitcnt vmcnt(0)" ::: "memory");
  }
  __syncthreads();
}

#define XB_TMO      128
#define XB_XCNT(j)  (256  + 64 * (j))
#define XB_XSUB(j)  (1280 + 64 * (j))
#define XB_XGEN(j)  (2304 + 64 * (j))
#define XB_TOP      3328
#define XB_TOPGEN   3392
#define XCD_BAR_WORDS 3456
#define XB_SPIN_CAP (1u << 18)
#define LAS __attribute__((address_space(3)))

__device__ __forceinline__ unsigned xb_ld(unsigned* p)              { return __hip_atomic_load(p, __ATOMIC_RELAXED, __HIP_MEMORY_SCOPE_AGENT); }
__device__ __forceinline__ unsigned xb_add(unsigned* p, unsigned v) { return __hip_atomic_fetch_add(p, v, __ATOMIC_RELAXED, __HIP_MEMORY_SCOPE_AGENT); }
__device__ __forceinline__ unsigned xb_xcc_id() { return (unsigned)__builtin_amdgcn_s_getreg((3 << 11) | 20) & 0xFu; }
#define XB_SPIN(cond, bar) do { unsigned _sp = 0; while (cond) { __builtin_amdgcn_s_sleep(1); \
    if ((++_sp & 255u) == 0u) { if (xb_ld(&(bar)[XB_TMO])) break; if (_sp > XB_SPIN_CAP) { atomicAdd(&(bar)[XB_TMO], 1u); break; } } } } while (0)

struct XcdBarrier {
    unsigned* bar; unsigned x;
    volatile LAS unsigned* st;
};

__device__ __forceinline__ XcdBarrier xcd_barrier_post(unsigned* bar, volatile LAS unsigned* st) {
    XcdBarrier b; b.bar = bar; b.x = xb_xcc_id(); b.st = st;
    if (threadIdx.x == 0) (void)xb_add(&bar[XB_XCNT(b.x)], 1u);
    return b;
}
__device__ __forceinline__ void xcd_barrier_complete(unsigned* bar, unsigned x, unsigned& nloc, unsigned& nx) {
    const unsigned G = gridDim.x * gridDim.y * gridDim.z;
    unsigned sum, cnt, mine, sp = 0u;
    for (;;) {
        sum = 0u; cnt = 0u; mine = 0u;
#pragma unroll
        for (unsigned j = 0; j < 16; ++j) { const unsigned c = xb_ld(&bar[XB_XCNT(j)]); sum += c; cnt += (c > 0u) ? 1u : 0u; mine = (j == x) ? c : mine; }
        if (sum == G) break;
        __builtin_amdgcn_s_sleep(1);
        if ((++sp & 255u) == 0u) { if (xb_ld(&bar[XB_TMO])) break; if (sp > XB_SPIN_CAP) { atomicAdd(&bar[XB_TMO], 1u); break; } }
    }
    nloc = mine > 0u ? mine : 1u; nx = cnt > 0u ? cnt : 1u;
}

__device__ __forceinline__ void xcd_barrier(const XcdBarrier& b) {
    asm volatile("s_waitcnt vmcnt(0)" ::: "memory");
    __syncthreads();
    if (threadIdx.x == 0) {
        unsigned* bar = b.bar;
        __builtin_amdgcn_s_waitcnt(0);
        unsigned nloc = b.st[0], nx = b.st[1];
        if (nloc == 0u) { xcd_barrier_complete(bar, b.x, nloc, nx); b.st[0] = nloc; b.st[1] = nx; }
        const unsigned old = xb_add(&bar[XB_XSUB(b.x)], 1u);
        const unsigned gen = old / nloc;
        if (old + 1u == (gen + 1u) * nloc) {
            __builtin_amdgcn_fence(__ATOMIC_RELEASE, "agent");
            asm volatile("s_waitcnt vmcnt(0)" ::: "memory");
            const unsigned og = xb_add(&bar[XB_TOP], 1u);
            const unsigned tg = og / nx;
            if (og + 1u == (tg + 1u) * nx) xb_add(&bar[XB_TOPGEN], 1u);
            else XB_SPIN(xb_ld(&bar[XB_TOPGEN]) == tg, bar);
            __builtin_amdgcn_fence(__ATOMIC_ACQUIRE, "agent");
            xb_add(&bar[XB_XGEN(b.x)], 1u);
            asm volatile("s_waitcnt vmcnt(0)" ::: "memory");
        } else {
            XB_SPIN(xb_ld(&bar[XB_XGEN(b.x)]) == gen, bar);
            __builtin_amdgcn_fence(__ATOMIC_ACQUIRE, "agent");
            asm volatile("s_waitcnt vmcnt(0)" ::: "memory");
        }
    }
    __syncthreads();
}

__global__ void __launch_bounds__(256, 2) mega(Params p) {
  extern __shared__ __attribute__((aligned(16))) unsigned char smem[];
  cg::grid_group grid = cg::this_grid();
  unsigned* bar = (unsigned*)(p.ws + OFF_BAR);
  unsigned epoch = 0; (void)epoch;
  volatile LAS unsigned* xb_st = (volatile LAS unsigned*)(smem + 65536 + 16);
  if (threadIdx.x == 0) { xb_st[0] = 0u; xb_st[1] = 0u; }
  __syncthreads();
  XcdBarrier xb = xcd_barrier_post(bar, xb_st);
#define grid_bar(b_, e_) xcd_barrier(xb)
  if (p.ph_hi > 1000) grid.sync();
  int cidx = 0;
#define PHASE(k, call) if (p.ph_lo <= (k) && (k) < p.ph_hi) { { const bool EPI_ON = true; (void)EPI_ON; call; } if ((REP_MASK >> (k)) & 1) { const bool EPI_ON = (REP_EPI != 0); (void)EPI_ON; grid_bar(bar, epoch); call; } if ((k) + 1 < p.ph_hi) grid_bar(bar, epoch); }
  const bool fuse_ln = (p.ph_hi - p.ph_lo == 10) && (((gridDim.x & 7) == 0) ? ((gridDim.x >> 3) >= 48) : (gridDim.x >= 384));
  PHASE(0, phase0(p, smem))
  PHASE(1, phase_h0(p))
  PHASE(2, gemm_phase<EPI_IN0>(p, smem, (const u16*)(p.ws + OFF_H), (const u16*)(p.ws + OFF_WIN0), 2560, EPI_ON))
  PHASE(3, attn0_phase(p, smem, cidx++))
  PHASE(4, gemm_phase<EPI_OUT0>(p, smem, (const u16*)(p.ws + OFF_AO), (const u16*)(p.ws + OFF_WOUT0), 1024, EPI_ON, fuse_ln))
  if (!fuse_ln) { PHASE(5, phase_ln<false>(p)) }
  PHASE(6, gemm_phase<EPI_IN1>(p, smem, (const u16*)(p.ws + OFF_H), (const u16*)(p.ws + OFF_WIN1), 4096, EPI_ON))
  PHASE(7, attn1_phase(p, smem, cidx++))
  if (fuse_ln) {
    if (p.ph_lo <= 8 && 8 < p.ph_hi) gemm_phase<EPI_OUT1>(p, smem, (const u16*)(p.ws + OFF_AO), (const u16*)(p.ws + OFF_WOUT1), 1024, true, true);
  } else {
    PHASE(8, gemm_phase<EPI_OUT1>(p, smem, (const u16*)(p.ws + OFF_AO), (const u16*)(p.ws + OFF_WOUT1), 1024, EPI_ON, false))
    PHASE(9, phase_ln<true>(p))
  }
}

extern "C" void kernel_launch(void* const* d_in, const int* in_sizes, int n_in, void* d_out, int out_size, void* d_ws,
                              size_t ws_size, hipStream_t stream) {
  static int grid_blocks = 0;
  if (!grid_blocks) {
    int dev = 0, cus = 0, per_cu = 0;
    (void)hipGetDevice(&dev);
    (void)hipDeviceGetAttribute(&cus, hipDeviceAttributeMultiprocessorCount, dev);
    if (hipFuncSetAttribute((const void*)mega, hipFuncAttributeMaxDynamicSharedMemorySize, LDS_BYTES) != hipSuccess)
      fprintf(stderr, "kernel_launch: hipFuncSetAttribute failed\n");
    if (hipOccupancyMaxActiveBlocksPerMultiprocessor(&per_cu, (const void*)mega, 256, LDS_BYTES) != hipSuccess || per_cu < 1) {
      fprintf(stderr, "kernel_launch: occupancy query gave %d\n", per_cu);
      per_cu = 1;
    }
    (void)hipGetLastError();
    if (per_cu > 2) per_cu = 2;
    if (cus <= 0) cus = 256;
    grid_blocks = cus * per_cu;
    if (ws_size < WS_END) fprintf(stderr, "kernel_launch: workspace too small\n");
  }
  (void)hipMemsetAsync((unsigned char*)d_ws + OFF_BAR, 0, BAR_BYTES, stream);
  Params p{};
  for (int i = 0; i < 26; ++i) p.in[i] = (const float*)d_in[i];
  p.out = (float*)d_out;
  p.ws = (unsigned char*)d_ws;
#if N_LAUNCH_MULTI
  for (int ph = 0; ph < 10; ++ph) {
    p.ph_lo = ph; p.ph_hi = ph + 1;
    hipLaunchKernelGGL(mega, dim3(grid_blocks), dim3(256), LDS_BYTES, stream, p);
  }
#else
  p.ph_lo = 0; p.ph_hi = 10;
  void* args[] = {&p};
  hipError_t e = hipLaunchCooperativeKernel((void*)mega, dim3(grid_blocks), dim3(256), args, LDS_BYTES, stream);
  if (e != hipSuccess) fprintf(stderr, "cooperative launch failed: %s (grid %d)\n", hipGetErrorString(e), grid_blocks);
#endif
}
```

```cpp
#include <hip/hip_runtime.h>
#include <hip/hip_cooperative_groups.h>
#include <cstdio>
namespace cg = cooperative_groups;

#ifndef GEMM_SKEW
#define GEMM_SKEW 0
#endif
#ifndef REP_EPI
#define REP_EPI 1
#endif
#ifndef REP_MASK
#define REP_MASK 0
#endif
#ifndef N_LAUNCH_MULTI
#define N_LAUNCH_MULTI 0
#endif

#define DI __device__ __forceinline__
typedef unsigned short u16;
using bf16x8 = __attribute__((ext_vector_type(8))) short;
using f32x4 = __attribute__((ext_vector_type(4))) float;
using f32x16 = __attribute__((ext_vector_type(16))) float;
typedef __bf16 bf2_t __attribute__((ext_vector_type(2)));
typedef float f2_t __attribute__((ext_vector_type(2)));

#define MFMA16(a, b, c) __builtin_amdgcn_mfma_f32_16x16x32_bf16((a), (b), (c), 0, 0, 0)
#define MFMA32(a, b, c) __builtin_amdgcn_mfma_f32_32x32x16_bf16((a), (b), (c), 0, 0, 0)

constexpr int M_CTX = 4096, M_ALL = 6144;
constexpr float ALPHA = 1.4142135623730951f;
constexpr float EPS = 1e-6f;
constexpr float LOG2E = 1.4426950408889634f;
constexpr float QSCALE = 0.125f * LOG2E;
constexpr float LAM_INIT = 0.35550906759096926f;

enum { I_XP = 0, I_XS, I_CAK, I_CAV, I_CBK, I_CBV, I_CCK, I_CCV, I_C, I_CCTX, I_WMOD, I_BMOD, I_LNG, I_LNB,
       I_WINE, I_WOUTE, I_QNA, I_KNA, I_SINK, I_WINO, I_WOUTO, I_LQ1, I_LK1, I_LQ2, I_LK2, I_SUBLN };

constexpr size_t O_YP = 0, O_YS = 4194304, O_AK = 6291456, O_AV = 6815744, O_BK = 7340032, O_BV = 7864320,
                 O_CK = 8388608, O_CV = 12582912;

constexpr size_t OFF_MOD = 0;
constexpr size_t OFF_ROPE = OFF_MOD + 73728;
constexpr size_t OFF_CNT = OFF_ROPE + 262144;
constexpr size_t OFF_WIN0 = OFF_CNT + 256;
constexpr size_t OFF_WOUT0 = OFF_WIN0 + 5242880;
constexpr size_t OFF_WIN1 = OFF_WOUT0 + 2097152;
constexpr size_t OFF_WOUT1 = OFF_WIN1 + 8388608;
constexpr size_t OFF_H = OFF_WOUT1 + 2097152;
constexpr size_t OFF_Q = OFF_H + 12582912;
constexpr size_t OFF_G = OFF_Q + 12582912;
constexpr size_t OFF_AO = OFF_G + 12582912;
constexpr size_t OFF_KCA = OFF_AO + 12582912;
constexpr size_t OFF_VCA = OFF_KCA + 1048576;
constexpr size_t OFF_KCB = OFF_VCA + 1048576;
constexpr size_t OFF_VCB = OFF_KCB + 1048576;
constexpr size_t OFF_KSA = OFF_VCB + 1048576;
constexpr size_t OFF_VSA = OFF_KSA + 655360;
constexpr size_t OFF_KSB = OFF_VSA + 655360;
constexpr size_t OFF_VSB = OFF_KSB + 655360;
constexpr size_t OFF_KCC = OFF_VSB + 655360;
constexpr size_t OFF_VCC = OFF_KCC + 8388608;
constexpr size_t OFF_KSC = OFF_VCC + 8388608;
constexpr size_t OFF_VSC = OFF_KSC + 5242880;
constexpr size_t OFF_R = OFF_VSC + 5242880;
constexpr size_t OFF_X1 = OFF_R + 25165824;
constexpr size_t OFF_BAR = OFF_X1 + 25165824;
constexpr size_t BAR_BYTES = 16384;
constexpr size_t OFF_PART = OFF_BAR + BAR_BYTES;
constexpr size_t WS_END = OFF_PART + 786432;
constexpr int BANDCNT_WORD = 3500;

constexpr int LDS_BYTES = 2 * 2 * 128 * 64 * 2 + 64;

struct Params {
  const float* in[26];
  float* out;
  unsigned char* ws;
  int ph_lo, ph_hi;
};

DI unsigned pack2(float a, float b) {
  f2_t v = {a, b};
  bf2_t r = __builtin_convertvector(v, bf2_t);
  return __builtin_bit_cast(unsigned, r);
}
DI u16 f2bf(float x) { return (u16)(pack2(x, 0.f) & 0xffffu); }
DI float bflo(unsigned u) { return __uint_as_float(u << 16); }
DI float bfhi(unsigned u) { return __uint_as_float(u & 0xffff0000u); }
DI float exp2f_fast(float x) { return __builtin_amdgcn_exp2f(x); }
DI float silu(float x) { return x * __builtin_amdgcn_rcpf(1.0f + __expf(-x)); }
typedef unsigned u32x4_t __attribute__((ext_vector_type(4)));
DI void st16_wt_raw(void* p, u32x4_t v) {
  asm volatile("global_store_dwordx4 %0, %1, off sc1\n\ts_nop 1" :: "v"(p), "v"(v) : "memory");
}
DI void st16_wt(void* p, uint4 v) { st16_wt_raw(p, u32x4_t{v.x, v.y, v.z, v.w}); }
DI void st16_wt(void* p, float4 v) {
  st16_wt_raw(p, u32x4_t{__float_as_uint(v.x), __float_as_uint(v.y), __float_as_uint(v.z), __float_as_uint(v.w)});
}
DI void st8_wt(void* p, uint2 v) {
  __hip_atomic_store((unsigned long long*)p, ((unsigned long long)v.y << 32) | v.x, __ATOMIC_RELAXED, __HIP_MEMORY_SCOPE_AGENT);
}
DI float wave_sum(float v) {
  v += __shfl_xor(v, 32); v += __shfl_xor(v, 16); v += __shfl_xor(v, 8);
  v += __shfl_xor(v, 4); v += __shfl_xor(v, 2); v += __shfl_xor(v, 1);
  return v;
}
DI float sum16(float v) {
  v += __shfl_xor(v, 8); v += __shfl_xor(v, 4); v += __shfl_xor(v, 2); v += __shfl_xor(v, 1);
  return v;
}
DI const float* xrow(const Params& p, int row) {
  return row < M_CTX ? p.in[I_XP] + (size_t)row * 1024 : p.in[I_XS] + (size_t)(row - M_CTX) * 1024;
}
DI int modvec(int row) { return row < M_CTX ? 0 : 1 + ((row - M_CTX) >> 10); }

DI void prep_item(const Params& p, unsigned char* smem, int item, int tid) {
  float* fs = (float*)smem;
  {
    if (item < 192) {
      const int l = item / 96, n0 = (item % 96) * 32;
      const int cq = tid & 7, kg = tid >> 3;
      const float* W = p.in[I_WMOD] + (size_t)l * 1024 * 3072 + n0 + cq * 4;
      const float* cc = p.in[I_CCTX];
      const float* c1 = p.in[I_C];
      float a0[4] = {0, 0, 0, 0}, a1[4] = {0, 0, 0, 0}, a2[4] = {0, 0, 0, 0};
      float* sl = fs + 4096;
#pragma unroll
      for (int j = 0; j < 12; ++j) {
        const int idx = tid + 256 * j, v = idx >> 10, k = idx & 1023;
        sl[idx] = silu(v == 0 ? cc[k] : c1[(v - 1) * 1024 + k]);
      }
      __syncthreads();
#pragma unroll 16
      for (int i = 0; i < 32; ++i) {
        const int k = kg * 32 + i;
        const f32x4 wv_ = __builtin_nontemporal_load((const f32x4*)(W + (size_t)k * 3072)); const float4 w = {wv_[0], wv_[1], wv_[2], wv_[3]};
        const float s0 = sl[k], s1 = sl[1024 + k], s2 = sl[2048 + k];
        a0[0] += s0 * w.x; a0[1] += s0 * w.y; a0[2] += s0 * w.z; a0[3] += s0 * w.w;
        a1[0] += s1 * w.x; a1[1] += s1 * w.y; a1[2] += s1 * w.z; a1[3] += s1 * w.w;
        a2[0] += s2 * w.x; a2[1] += s2 * w.y; a2[2] += s2 * w.z; a2[3] += s2 * w.w;
      }
#pragma unroll
      for (int e = 0; e < 4; ++e) {
        fs[kg * 96 + 0 + cq * 4 + e] = a0[e];
        fs[kg * 96 + 32 + cq * 4 + e] = a1[e];
        fs[kg * 96 + 64 + cq * 4 + e] = a2[e];
      }
      __syncthreads();
      if (tid < 96) {
        float s = 0;
        for (int g = 0; g < 32; ++g) s += fs[g * 96 + tid];
        const int v = tid >> 5, col = n0 + (tid & 31);
        s += p.in[I_BMOD][l * 3072 + col];
        ((float*)(p.ws + OFF_MOD))[(l * 3 + v) * 3072 + col] = s;
      }
      __syncthreads();
    } else {
      int t = item - 192;
      const float* W; u16* Wt; int N;
      if (t < 640) { W = p.in[I_WINE]; Wt = (u16*)(p.ws + OFF_WIN0); N = 2560; }
      else if (t < 896) { t -= 640; W = p.in[I_WOUTE]; Wt = (u16*)(p.ws + OFF_WOUT0); N = 1024; }
      else if (t < 1920) { t -= 896; W = p.in[I_WINO]; Wt = (u16*)(p.ws + OFF_WIN1); N = 4096; }
      else { t -= 1920; W = p.in[I_WOUTO]; Wt = (u16*)(p.ws + OFF_WOUT1); N = 1024; }
      const int nt = N / 64;
      const int k0 = (t / nt) * 64, n0 = (t % nt) * 64;
#pragma unroll
      for (int i = 0; i < 4; ++i) {
        const int idx = tid + 256 * i;
        const int row = idx >> 4, c4 = idx & 15;
        const f32x4 wv_ = __builtin_nontemporal_load((const f32x4*)(W + (size_t)(k0 + row) * N + n0 + c4 * 4)); const float4 w = {wv_[0], wv_[1], wv_[2], wv_[3]};
        fs[row * 65 + c4 * 4 + 0] = w.x; fs[row * 65 + c4 * 4 + 1] = w.y;
        fs[row * 65 + c4 * 4 + 2] = w.z; fs[row * 65 + c4 * 4 + 3] = w.w;
      }
      __syncthreads();
#pragma unroll
      for (int i = 0; i < 2; ++i) {
        const int idx = tid + 256 * i;
        const int n = idx >> 3, kc = idx & 7;
        uint4 o;
        o.x = pack2(fs[(kc * 8 + 0) * 65 + n], fs[(kc * 8 + 1) * 65 + n]);
        o.y = pack2(fs[(kc * 8 + 2) * 65 + n], fs[(kc * 8 + 3) * 65 + n]);
        o.z = pack2(fs[(kc * 8 + 4) * 65 + n], fs[(kc * 8 + 5) * 65 + n]);
        o.w = pack2(fs[(kc * 8 + 6) * 65 + n], fs[(kc * 8 + 7) * 65 + n]);
        st16_wt(Wt + (size_t)(n0 + n) * 1024 + k0 + kc * 8, o);
      }
      __syncthreads();
    }
  }
}
DI void phase0(const Params& p, unsigned char* smem) {
  const int tid = threadIdx.x;
  const int b = blockIdx.x, nb = gridDim.x;
  for (int item = b; item < 192; item += nb) prep_item(p, smem, item, tid);
  if (nb >= 384) {
    if (b < 192) { prep_item(p, smem, 192 + b, tid); prep_item(p, smem, 192 + 192 + b, tid); }
    else for (int t = 384 + (b - 192); t < 2176; t += nb - 192) prep_item(p, smem, 192 + t, tid);
  } else {
    for (int t = b; t < 2176; t += nb) prep_item(p, smem, 192 + t, tid);
  }
  const int gtid = blockIdx.x * 256 + tid, gsz = gridDim.x * 256;
  if (gtid < 64) ((int*)(p.ws + OFF_CNT))[gtid] = 0;
  float* tab = (float*)(p.ws + OFF_ROPE);
  for (int idx = gtid; idx < 1024 * 32; idx += gsz) {
    const int s = idx >> 5, i = idx & 31, which = i >> 4, fi = i & 15;
    const float pos = (float)(which ? (s & 63) : (s >> 6));
    const float freq = exp2f(-(float)fi * (13.287712379549449f / 16.0f));
    float tr = pos * freq * 0.15915494309189535f;
    tr = tr - floorf(tr);
    tab[s * 64 + which * 32 + fi] = __builtin_amdgcn_cosf(tr);
    tab[s * 64 + which * 32 + 16 + fi] = __builtin_amdgcn_sinf(tr);
  }
  for (int idx = gtid; idx < 2 * 256 * 128; idx += gsz) {
    const int b = idx >> 15, s = (idx >> 7) & 255, kvh = (idx >> 6) & 1, d = idx & 63;
    const size_t ko = ((size_t)(b * 2 + kvh) * 1280 + 1024 + s) * 64 + d;
    const size_t vo = ((size_t)(b * 2 + kvh) * 64 + d) * 1280 + 1024 + s;
    ((u16*)(p.ws + OFF_KSA))[ko] = f2bf(p.in[I_CAK][idx]);
    ((u16*)(p.ws + OFF_VSA))[vo] = f2bf(p.in[I_CAV][idx]);
    ((u16*)(p.ws + OFF_KSB))[ko] = f2bf(p.in[I_CBK][idx]);
    ((u16*)(p.ws + OFF_VSB))[vo] = f2bf(p.in[I_CBV][idx]);
  }
  for (int idx = gtid; idx < 2 * 256 * 1024; idx += gsz) {
    const int b = idx >> 18, s = (idx >> 10) & 255, col = idx & 1023;
    const int hh = col >> 6, d = col & 63, head = col >> 7, dv = col & 127;
    ((u16*)(p.ws + OFF_KSC))[((size_t)(b * 16 + hh) * 1280 + 1024 + s) * 64 + d] = f2bf(p.in[I_CCK][idx]);
    ((u16*)(p.ws + OFF_VSC))[(size_t)(b * 8 + head) * 128 * 1280 + ((size_t)((1024 + s) >> 5) * 128 + dv) * 32 + (s & 31)] = f2bf(p.in[I_CCV][idx]);
  }
}

DI void phase_h0(const Params& p) {
  const int gtid = blockIdx.x * 256 + threadIdx.x, gsz = gridDim.x * 256;
  const float* mod = (const float*)(p.ws + OFF_MOD);
  u16* H = (u16*)(p.ws + OFF_H);
  for (int idx = gtid; idx < M_ALL * 128; idx += gsz) {
    const int row = idx >> 7, c = (idx & 127) * 8;
    const float* x = xrow(p, row) + c;
    const float* mv = mod + modvec(row) * 3072;
    const float4 x0 = *(const float4*)x, x1 = *(const float4*)(x + 4);
    const float4 sh0 = *(const float4*)(mv + c), sh1 = *(const float4*)(mv + c + 4);
    const float4 sc0 = *(const float4*)(mv + 1024 + c), sc1 = *(const float4*)(mv + 1024 + c + 4);
    uint4 o;
    o.x = pack2(x0.x * (1.f + sc0.x) + sh0.x, x0.y * (1.f + sc0.y) + sh0.y);
    o.y = pack2(x0.z * (1.f + sc0.z) + sh0.z, x0.w * (1.f + sc0.w) + sh0.w);
    o.z = pack2(x1.x * (1.f + sc1.x) + sh1.x, x1.y * (1.f + sc1.y) + sh1.y);
    o.w = pack2(x1.z * (1.f + sc1.z) + sh1.z, x1.w * (1.f + sc1.w) + sh1.w);
    st16_wt(H + (size_t)row * 1024 + c, o);
  }
}

template <bool FINAL>
DI void phase_ln(const Params& p) {
  const int lane = threadIdx.x & 63;
  const int gw = blockIdx.x * 4 + (threadIdx.x >> 6), nw = gridDim.x * 4;
  const int l = FINAL ? 1 : 0;
  const float* R = (const float*)(p.ws + OFF_R);
  const float* g = p.in[I_LNG] + l * 1024;
  const float* bb = p.in[I_LNB] + l * 1024;
  for (int row = gw; row < M_ALL; row += nw) {
    float4 v[4];
    float s = 0;
#pragma unroll
    for (int i = 0; i < 4; ++i) {
      v[i] = *(const float4*)(R + (size_t)row * 1024 + i * 256 + lane * 4);
      s += v[i].x + v[i].y + v[i].z + v[i].w;
    }
    const float mu = wave_sum(s) * (1.0f / 1024.0f);
    float q = 0;
#pragma unroll
    for (int i = 0; i < 4; ++i) {
      v[i].x -= mu; v[i].y -= mu; v[i].z -= mu; v[i].w -= mu;
      q += v[i].x * v[i].x + v[i].y * v[i].y + v[i].z * v[i].z + v[i].w * v[i].w;
    }
    const float rs = rsqrtf(wave_sum(q) * (1.0f / 1024.0f) + EPS);
#pragma unroll
    for (int i = 0; i < 4; ++i) {
      const int c = i * 256 + lane * 4;
      const float4 gg = *(const float4*)(g + c), be = *(const float4*)(bb + c);
      float4 y;
      y.x = v[i].x * rs * gg.x + be.x; y.y = v[i].y * rs * gg.y + be.y;
      y.z = v[i].z * rs * gg.z + be.z; y.w = v[i].w * rs * gg.w + be.w;
      if (FINAL) {
        st16_wt(p.out + (size_t)row * 1024 + c, y);
      } else {
        st16_wt((float*)(p.ws + OFF_X1) + (size_t)row * 1024 + c, y);
        const float* mv = (const float*)(p.ws + OFF_MOD) + (3 + modvec(row)) * 3072;
        const float4 sh = *(const float4*)(mv + c), sc = *(const float4*)(mv + 1024 + c);
        uint2 o;
        o.x = pack2(y.x * (1.f + sc.x) + sh.x, y.y * (1.f + sc.y) + sh.y);
        o.y = pack2(y.z * (1.f + sc.z) + sh.z, y.w * (1.f + sc.w) + sh.w);
        st8_wt((u16*)(p.ws + OFF_H) + (size_t)row * 1024 + c, o);
      }
    }
  }
}

DI void rope_T(const Params& p, f32x4 (&acc)[4][4], int rbase, int lane) {
  const float* tab = (const float*)(p.ws + OFF_ROPE);
  const int l15 = lane & 15, f0 = (lane >> 4) * 4;
#pragma unroll
  for (int mi = 0; mi < 4; ++mi) {
    const int s = (rbase + mi * 16 + l15 - M_CTX) & 1023;
    const float* t = tab + s * 64 + f0;
    const float4 cr = *(const float4*)(t), sr = *(const float4*)(t + 16), cc = *(const float4*)(t + 32), sc = *(const float4*)(t + 48);
    const float crv[4] = {cr.x, cr.y, cr.z, cr.w}, srv[4] = {sr.x, sr.y, sr.z, sr.w};
    const float ccv[4] = {cc.x, cc.y, cc.z, cc.w}, scv[4] = {sc.x, sc.y, sc.z, sc.w};
#pragma unroll
    for (int j = 0; j < 4; ++j) {
      const float x1 = acc[0][mi][j], x2 = acc[1][mi][j], y1 = acc[2][mi][j], y2 = acc[3][mi][j];
      acc[0][mi][j] = x1 * crv[j] - x2 * srv[j]; acc[1][mi][j] = x1 * srv[j] + x2 * crv[j];
      acc[2][mi][j] = y1 * ccv[j] - y2 * scv[j]; acc[3][mi][j] = y1 * scv[j] + y2 * ccv[j];
    }
  }
}
DI void rms_T(f32x4 (&acc)[4][4], const float* w, int lane) {
  const int f0 = (lane >> 4) * 4;
  float4 wv[4];
#pragma unroll
  for (int ni = 0; ni < 4; ++ni) wv[ni] = *(const float4*)(w + ni * 16 + f0);
#pragma unroll
  for (int mi = 0; mi < 4; ++mi) {
    float ss = 0;
#pragma unroll
    for (int ni = 0; ni < 4; ++ni)
#pragma unroll
      for (int j = 0; j < 4; ++j) ss += acc[ni][mi][j] * acc[ni][mi][j];
    ss += __shfl_xor(ss, 16);
    ss += __shfl_xor(ss, 32);
    const float r = rsqrtf(ss * (1.0f / 64.0f) + EPS);
#pragma unroll
    for (int ni = 0; ni < 4; ++ni) {
      acc[ni][mi][0] *= r * wv[ni].x; acc[ni][mi][1] *= r * wv[ni].y;
      acc[ni][mi][2] *= r * wv[ni].z; acc[ni][mi][3] *= r * wv[ni].w;
    }
  }
}
DI void store_bf16_T(f32x4 (&acc)[4][4], u16* dst, size_t ld, int lane, float scale) {
  const int l15 = lane & 15, f0 = (lane >> 4) * 4;
#pragma unroll
  for (int mi = 0; mi < 4; ++mi)
#pragma unroll
    for (int ni = 0; ni < 4; ++ni) {
      uint2 o;
      o.x = pack2(acc[ni][mi][0] * scale, acc[ni][mi][1] * scale);
      o.y = pack2(acc[ni][mi][2] * scale, acc[ni][mi][3] * scale);
      *(uint2*)(dst + (size_t)(mi * 16 + l15) * ld + ni * 16 + f0) = o;
    }
}
DI void store_f32_T(f32x4 (&acc)[4][4], float* dst, size_t ld, int lane) {
  const int l15 = lane & 15, f0 = (lane >> 4) * 4;
#pragma unroll
  for (int mi = 0; mi < 4; ++mi)
#pragma unroll
    for (int ni = 0; ni < 4; ++ni) {
      float4 o = {acc[ni][mi][0], acc[ni][mi][1], acc[ni][mi][2], acc[ni][mi][3]};
      *(float4*)(dst + (size_t)(mi * 16 + l15) * ld + ni * 16 + f0) = o;
    }
}
DI void silu_tile(f32x4 (&acc)[4][4]) {
#pragma unroll
  for (int a = 0; a < 4; ++a)
#pragma unroll
    for (int b = 0; b < 4; ++b)
#pragma unroll
      for (int j = 0; j < 4; ++j) acc[a][b][j] = silu(acc[a][b][j]);
}
DI void stage_bf16_T(f32x4 (&acc)[4][4], unsigned char* stg, u16* dst, size_t ld, int lane, float scale) {
  const int l15 = lane & 15, g = lane >> 4;
#pragma unroll
  for (int mi = 0; mi < 4; ++mi)
#pragma unroll
    for (int ni = 0; ni < 4; ++ni) {
      uint2 o;
      o.x = pack2(acc[ni][mi][0] * scale, acc[ni][mi][1] * scale);
      o.y = pack2(acc[ni][mi][2] * scale, acc[ni][mi][3] * scale);
      *(uint2*)(stg + (mi * 16 + l15) * 144 + ni * 32 + g * 8) = o;
    }
  uint4 v[8];
#pragma unroll
  for (int i = 0; i < 8; ++i) {
    const int id = lane + 64 * i, row = id >> 3, c = id & 7;
    v[i] = *(const uint4*)(stg + row * 144 + c * 16);
  }
#pragma unroll
  for (int i = 0; i < 8; ++i) {
    const int id = lane + 64 * i, row = id >> 3, c = id & 7;
    st16_wt(dst + (size_t)row * ld + c * 8, v[i]);
  }
}
DI void stage_f32_half_T(f32x4 (&acc)[4][4], unsigned char* stg, int half, int lane) {
  const int l15 = lane & 15, g = lane >> 4;
#pragma unroll
  for (int m2 = 0; m2 < 2; ++m2)
#pragma unroll
    for (int ni = 0; ni < 4; ++ni) {
      const int mi = half * 2 + m2;
      float4 o = {acc[ni][mi][0], acc[ni][mi][1], acc[ni][mi][2], acc[ni][mi][3]};
      *(float4*)(stg + (m2 * 16 + l15) * 272 + (ni * 16 + g * 4) * 4) = o;
    }
}
DI void stage_f32_T(f32x4 (&acc)[4][4], unsigned char* stg, float* dst, size_t ld, int lane) {
#pragma unroll
  for (int half = 0; half < 2; ++half) {
    stage_f32_half_T(acc, stg, half, lane);
    float4 v[8];
#pragma unroll
    for (int i = 0; i < 8; ++i) {
      const int id = lane + 64 * i, row = id >> 4, c = id & 15;
      v[i] = *(const float4*)(stg + row * 272 + c * 16);
    }
#pragma unroll
    for (int i = 0; i < 8; ++i) {
      const int id = lane + 64 * i, row = id >> 4, c = id & 15;
      st16_wt(dst + (size_t)(half * 32 + row) * ld + c * 4, v[i]);
    }
  }
}
DI void store_f32_N(f32x4 (&acc)[4][4], float* dst, size_t ld, int lane) {
  const int c = lane & 15, rq = (lane >> 4) * 4;
#pragma unroll
  for (int mi = 0; mi < 4; ++mi)
#pragma unroll
    for (int j = 0; j < 4; ++j)
#pragma unroll
      for (int ni = 0; ni < 4; ++ni) dst[(size_t)(mi * 16 + rq + j) * ld + ni * 16 + c] = acc[mi][ni][j];
}
DI void store_tr_N(f32x4 (&acc)[4][4], u16* dst, size_t ld, int lane) {
  const int c = lane & 15, rq = (lane >> 4) * 4;
#pragma unroll
  for (int mi = 0; mi < 4; ++mi)
#pragma unroll
    for (int ni = 0; ni < 4; ++ni) {
      uint2 o;
      o.x = pack2(acc[mi][ni][0], acc[mi][ni][1]);
      o.y = pack2(acc[mi][ni][2], acc[mi][ni][3]);
      st8_wt(dst + (size_t)(ni * 16 + c) * ld + mi * 16 + rq, o);
    }
}
DI void store_k(const Params& p, f32x4 (&acc)[4][4], unsigned char* stg, int rbase, int lane, int nh, int hidx, size_t off_kc, size_t off_ks) {
  if (rbase < M_CTX) {
    const int b = rbase >> 8, s0 = rbase & 255;
    stage_bf16_T(acc, stg, (u16*)(p.ws + off_kc) + ((size_t)(b * nh + hidx) * 256 + s0) * 64, 64, lane, 1.0f);
  } else {
    const int r = rbase - M_CTX, b = r >> 10, s0 = r & 1023;
    stage_bf16_T(acc, stg, (u16*)(p.ws + off_ks) + ((size_t)(b * nh + hidx) * 1280 + s0) * 64, 64, lane, 1.0f);
  }
}
DI void store_tr_tiled_N(f32x4 (&acc)[4][4], u16* head_base, int dv0, int s0, int lane) {
  const int c = lane & 15, rq = (lane >> 4) * 4;
#pragma unroll
  for (int mi = 0; mi < 4; ++mi)
#pragma unroll
    for (int ni = 0; ni < 4; ++ni) {
      uint2 o;
      o.x = pack2(acc[mi][ni][0], acc[mi][ni][1]);
      o.y = pack2(acc[mi][ni][2], acc[mi][ni][3]);
      const int t = s0 + mi * 16 + rq;
      st8_wt(head_base + ((size_t)(t >> 5) * 128 + dv0 + ni * 16 + c) * 32 + (t & 31), o);
    }
}
DI void store_v(const Params& p, f32x4 (&acc)[4][4], int rbase, int lane, int nh, int hidx, int dvh, int dv0, size_t off_vc, size_t off_vs) {
  if (rbase < M_CTX) {
    const int b = rbase >> 8, s0 = rbase & 255;
    if (dvh == 128) store_tr_tiled_N(acc, (u16*)(p.ws + off_vc) + (size_t)(b * nh + hidx) * 128 * 256, dv0, s0, lane);
    else store_tr_N(acc, (u16*)(p.ws + off_vc) + ((size_t)(b * nh + hidx) * dvh + dv0) * 256 + s0, 256, lane);
  } else {
    const int r = rbase - M_CTX, b = r >> 10, s0 = r & 1023;
    if (dvh == 128) store_tr_tiled_N(acc, (u16*)(p.ws + off_vs) + (size_t)(b * nh + hidx) * 128 * 1280, dv0, s0, lane);
    else store_tr_N(acc, (u16*)(p.ws + off_vs) + ((size_t)(b * nh + hidx) * dvh + dv0) * 1280 + s0, 1280, lane);
  }
}

enum { EPI_IN0 = 0, EPI_OUT0 = 1, EPI_IN1 = 2, EPI_OUT1 = 3 };

template <int EPI>
DI bool is_v_tile(int n0) {
  if (EPI == EPI_IN0) return n0 == 640 || n0 == 1920;
  if (EPI == EPI_IN1) return n0 >= 2048 && n0 < 3072;
  return false;
}

template <int EPI>
DI void epilogue(const Params& p, f32x4 (&acc)[4][4], unsigned char* stg, int rbase, int cb, int lane) {
  const bool smp = rbase >= M_CTX;
  u16* Q = (u16*)(p.ws + OFF_Q);
  u16* G = (u16*)(p.ws + OFF_G);
  if (EPI == EPI_IN0) {
    if (cb < 512) {
      rms_T(acc, p.in[I_QNA], lane);
      if (smp) rope_T(p, acc, rbase, lane);
      stage_bf16_T(acc, stg, Q + (size_t)rbase * 1024 + cb, 1024, lane, QSCALE);
    } else if (cb < 640) {
      const int kvh = (cb - 512) >> 6;
      rms_T(acc, p.in[I_KNA], lane);
      if (!smp) stage_f32_T(acc, stg, p.out + O_AK + (size_t)rbase * 128 + kvh * 64, 128, lane);
      else rope_T(p, acc, rbase, lane);
      store_k(p, acc, stg, rbase, lane, 2, kvh, OFF_KCA, OFF_KSA);
    } else if (cb < 768) {
      const int kvh = (cb - 640) >> 6;
      if (!smp) store_f32_N(acc, p.out + O_AV + (size_t)rbase * 128 + kvh * 64, 128, lane);
      store_v(p, acc, rbase, lane, 2, kvh, 64, 0, OFF_VCA, OFF_VSA);
    } else if (cb < 1280) {
      silu_tile(acc);
      stage_bf16_T(acc, stg, G + (size_t)rbase * 1024 + (cb - 768), 1024, lane, 1.0f);
    } else if (cb < 1792) {
      if (smp) rope_T(p, acc, rbase, lane);
      stage_bf16_T(acc, stg, Q + (size_t)rbase * 1024 + 512 + (cb - 1280), 1024, lane, QSCALE);
    } else if (cb < 1920) {
      const int kvh = (cb - 1792) >> 6;
      if (!smp) stage_f32_T(acc, stg, p.out + O_BK + (size_t)rbase * 128 + kvh * 64, 128, lane);
      else rope_T(p, acc, rbase, lane);
      store_k(p, acc, stg, rbase, lane, 2, kvh, OFF_KCB, OFF_KSB);
    } else if (cb < 2048) {
      const int kvh = (cb - 1920) >> 6;
      if (!smp) store_f32_N(acc, p.out + O_BV + (size_t)rbase * 128 + kvh * 64, 128, lane);
      store_v(p, acc, rbase, lane, 2, kvh, 64, 0, OFF_VCB, OFF_VSB);
    } else {
      silu_tile(acc);
      stage_bf16_T(acc, stg, G + (size_t)rbase * 1024 + 512 + (cb - 2048), 1024, lane, 1.0f);
    }
  } else if (EPI == EPI_IN1) {
    if (cb < 1024) {
      if (smp) rope_T(p, acc, rbase, lane);
      stage_bf16_T(acc, stg, Q + (size_t)rbase * 1024 + cb, 1024, lane, QSCALE);
    } else if (cb < 2048) {
      const int hh = (cb - 1024) >> 6;
      if (!smp) stage_f32_T(acc, stg, p.out + O_CK + (size_t)rbase * 1024 + (cb - 1024), 1024, lane);
      else rope_T(p, acc, rbase, lane);
      store_k(p, acc, stg, rbase, lane, 16, hh, OFF_KCC, OFF_KSC);
    } else if (cb < 3072) {
      const int head = (cb - 2048) >> 7, dv0 = (cb - 2048) & 127;
      if (!smp) store_f32_N(acc, p.out + O_CV + (size_t)rbase * 1024 + (cb - 2048), 1024, lane);
      store_v(p, acc, rbase, lane, 8, head, 128, dv0, OFF_VCC, OFF_VSC);
    } else {
      silu_tile(acc);
      stage_bf16_T(acc, stg, G + (size_t)rbase * 1024 + (cb - 3072), 1024, lane, 1.0f);
    }
  } else {
    const int l = (EPI == EPI_OUT0) ? 0 : 1;
    const float* gate = (const float*)(p.ws + OFF_MOD) + (l * 3 + modvec(rbase)) * 3072 + 2048 + cb;
    const float* xres = ((EPI == EPI_OUT0) ? xrow(p, rbase) : (const float*)(p.ws + OFF_X1) + (size_t)rbase * 1024) + cb;
    float* R = (float*)(p.ws + OFF_R) + (size_t)rbase * 1024 + cb;
    const int c = lane & 15;
    const float4 gv = *(const float4*)(gate + c * 4);
#pragma unroll
    for (int half = 0; half < 2; ++half) {
      stage_f32_half_T(acc, stg, half, lane);
#pragma unroll
      for (int i = 0; i < 8; ++i) {
        const int row = (lane >> 4) + 4 * i;
        const float4 a = *(const float4*)(stg + row * 272 + c * 16);
        const size_t o = (size_t)(half * 32 + row) * 1024 + c * 4;
        const float4 x = *(const float4*)(xres + o);
        float4 r;
        r.x = ALPHA * x.x + gv.x * a.x; r.y = ALPHA * x.y + gv.y * a.y;
        r.z = ALPHA * x.z + gv.z * a.z; r.w = ALPHA * x.w + gv.w * a.w;
        st16_wt(R + o, r);
      }
    }
  }
}

DI void gemm_stage(const u16* ag, const u16* bg, u16* sa, u16* sb, int tid, int k0) {
#pragma unroll
  for (int i = 0; i < 4; ++i) {
    const int id = tid + 256 * i;
    const int row = id >> 3, c = (id & 7) ^ ((row >> 1) & 7);
    __builtin_amdgcn_global_load_lds((const unsigned*)(ag + (size_t)row * 1024 + k0 + c * 8), (unsigned*)(sa + id * 8), 16, 0, 0);
    __builtin_amdgcn_global_load_lds((const unsigned*)(bg + (size_t)row * 1024 + k0 + c * 8), (unsigned*)(sb + id * 8), 16, 0, 0);
  }
}

template <bool SWAP>
DI void gemm_mainloop(const u16* ag, const u16* bg, u16* sA, u16* sB, int tid, int wm, int wn, f32x4 (&acc)[4][4]) {
  const int lane = tid & 63;
#pragma unroll
  for (int a = 0; a < 4; ++a)
#pragma unroll
    for (int b = 0; b < 4; ++b) acc[a][b] = f32x4{0.f, 0.f, 0.f, 0.f};
  gemm_stage(ag, bg, sA, sB, tid, 0);
  __syncthreads();
  const int ra = wm * 64 + (lane & 15), rb = wn * 64 + (lane & 15);
  const int swa = (ra >> 1) & 7, swb = (rb >> 1) & 7;
  const int q = lane >> 4;
#pragma unroll 2
  for (int kt = 0; kt < 16; ++kt) {
    const int cur = kt & 1;
    if (kt + 1 < 16) gemm_stage(ag, bg, sA + (cur ^ 1) * 8192, sB + (cur ^ 1) * 8192, tid, (kt + 1) * 64);
    const u16* a_s = sA + cur * 8192 + ra * 64;
    const u16* b_s = sB + cur * 8192 + rb * 64;
#pragma unroll
    for (int ks = 0; ks < 2; ++ks) {
      bf16x8 af[4], bfr[4];
#pragma unroll
      for (int mi = 0; mi < 4; ++mi) af[mi] = *(const bf16x8*)(a_s + mi * 16 * 64 + (((ks * 4 + q) ^ swa) * 8));
#pragma unroll
      for (int ni = 0; ni < 4; ++ni) bfr[ni] = *(const bf16x8*)(b_s + ni * 16 * 64 + (((ks * 4 + q) ^ swb) * 8));
#pragma unroll
      for (int a = 0; a < 4; ++a)
#pragma unroll
        for (int b = 0; b < 4; ++b) {
          if (SWAP) acc[a][b] = MFMA16(bfr[a], af[b], acc[a][b]);
          else acc[a][b] = MFMA16(af[a], bfr[b], acc[a][b]);
        }
    }
    __syncthreads();
  }
}

template <int EPI>
DI void gemm_phase(const Params& p, unsigned char* smem, const u16* A, const u16* Wt, int N, bool do_epi = true, bool fuse_ln = false) {
  const int tid = threadIdx.x, lane = tid & 63, wave = tid >> 6;
  const int wm = wave >> 1, wn = wave & 1;
  const int NT = N >> 7;
  const int ntiles = 48 * NT;
  u16* sA = (u16*)smem;
  u16* sB = sA + 2 * 8192;
#if GEMM_SKEW
  if (blockIdx.x >= (gridDim.x >> 1)) { for (int i = 0; i < GEMM_SKEW; ++i) __builtin_amdgcn_s_sleep(127); }
#endif
  const bool xcd_map = (gridDim.x & 7) == 0;
  const int nslot = xcd_map ? (gridDim.x >> 3) : gridDim.x;
  const int slot = xcd_map ? (blockIdx.x >> 3) : blockIdx.x;
  const int nloc = xcd_map ? 6 * NT : ntiles;
  for (int j = slot; j < nloc; j += nslot) {
    int tm, tn;
    if (xcd_map) { tn = j / 6; tm = (blockIdx.x & 7) * 6 + (j - tn * 6); }
    else { tm = j / NT; tn = j - tm * NT; }
    const int m0 = tm * 128, n0 = tn * 128;
    f32x4 acc[4][4];
    const u16* ag = A + (size_t)m0 * 1024;
    const u16* bg = Wt + (size_t)n0 * 1024;
    if (is_v_tile<EPI>(n0)) gemm_mainloop<false>(ag, bg, sA, sB, tid, wm, wn, acc);
    else gemm_mainloop<true>(ag, bg, sA, sB, tid, wm, wn, acc);
    int lane_e = lane;
    asm volatile("" : "+v"(lane_e));
    if (do_epi && fuse_ln && (EPI == EPI_OUT0 || EPI == EPI_OUT1))
      epilogue_ln<(EPI == EPI_OUT1) ? EPI_OUT1 : EPI_OUT0>(p, acc, smem + wave * 9216, m0 + wm * 64, n0 + wn * 64, lane_e, tm, tn * 2 + wn);
    else if (do_epi) epilogue<EPI>(p, acc, smem + wave * 9216, m0 + wm * 64, n0 + wn * 64, lane_e);
    else if (p.ph_hi > 1000) {
      float s = 0;
      for (int a = 0; a < 4; ++a) for (int b = 0; b < 4; ++b) s += acc[a][b][0] + acc[a][b][1] + acc[a][b][2] + acc[a][b][3];
      p.out[lane_e] = s;
    }
    __syncthreads();
  }
}

DI unsigned band_ld(unsigned* p) { return __hip_atomic_load(p, __ATOMIC_RELAXED, __HIP_MEMORY_SCOPE_AGENT); }
template <int EPI>
DI void epilogue_ln(const Params& p, f32x4 (&acc)[4][4], unsigned char* stg, int rbase, int cb, int lane, int tm, int slot16) {
  constexpr int l = (EPI == EPI_OUT0) ? 0 : 1;
  const int l15 = lane & 15, g = lane >> 4, f0 = g * 4;
  const float* mod = (const float*)(p.ws + OFF_MOD);
  const int mv = modvec(rbase);
  {
    const float* gate = mod + (l * 3 + mv) * 3072 + 2048 + cb + f0;
    const float* xres = ((EPI == EPI_OUT0) ? xrow(p, rbase) : (const float*)(p.ws + OFF_X1) + (size_t)rbase * 1024) + cb + f0;
    float4 gv[4];
#pragma unroll
    for (int ni = 0; ni < 4; ++ni) gv[ni] = *(const float4*)(gate + ni * 16);
#pragma unroll
    for (int mi = 0; mi < 4; ++mi)
#pragma unroll
      for (int ni = 0; ni < 4; ++ni) {
        const float4 x = *(const float4*)(xres + (size_t)(mi * 16 + l15) * 1024 + ni * 16);
        acc[ni][mi][0] = ALPHA * x.x + gv[ni].x * acc[ni][mi][0]; acc[ni][mi][1] = ALPHA * x.y + gv[ni].y * acc[ni][mi][1];
        acc[ni][mi][2] = ALPHA * x.z + gv[ni].z * acc[ni][mi][2]; acc[ni][mi][3] = ALPHA * x.w + gv[ni].w * acc[ni][mi][3];
      }
  }
  unsigned long long* part = (unsigned long long*)(p.ws + OFF_PART);
#pragma unroll
  for (int mi = 0; mi < 4; ++mi) {
    float s = 0.f, q = 0.f;
#pragma unroll
    for (int ni = 0; ni < 4; ++ni)
#pragma unroll
      for (int j = 0; j < 4; ++j) { s += acc[ni][mi][j]; q += acc[ni][mi][j] * acc[ni][mi][j]; }
    s += __shfl_xor(s, 16); s += __shfl_xor(s, 32);
    q += __shfl_xor(q, 16); q += __shfl_xor(q, 32);
    if (g == 0) st8_wt(part + (size_t)(rbase + mi * 16 + l15) * 16 + slot16, uint2{__float_as_uint(s), __float_as_uint(q)});
  }
  asm volatile("s_waitcnt vmcnt(0)" ::: "memory");
  __syncthreads();
  if (threadIdx.x == 0) {
    unsigned* bc = (unsigned*)(p.ws + OFF_BAR) + BANDCNT_WORD + l * 48 + tm;
    __hip_atomic_fetch_add(bc, 1u, __ATOMIC_RELAXED, __HIP_MEMORY_SCOPE_AGENT);
    unsigned spins = 0;
    while (band_ld(bc) < 8u && ++spins < (1u << 22)) __builtin_amdgcn_s_sleep(1);
    __builtin_amdgcn_fence(__ATOMIC_ACQUIRE, "agent");
    asm volatile("s_waitcnt vmcnt(0)" ::: "memory");
  }
  __syncthreads();
  const float* lg = p.in[I_LNG] + l * 1024 + cb + f0;
  const float* lb = p.in[I_LNB] + l * 1024 + cb + f0;
  float4 gam[4], bet[4];
#pragma unroll
  for (int ni = 0; ni < 4; ++ni) { gam[ni] = *(const float4*)(lg + ni * 16); bet[ni] = *(const float4*)(lb + ni * 16); }
#pragma unroll
  for (int mi = 0; mi < 4; ++mi) {
    unsigned long long* pr = part + (size_t)(rbase + mi * 16 + l15) * 16 + g * 4;
    float s = 0.f, q = 0.f;
#pragma unroll
    for (int k = 0; k < 4; ++k) {
      const unsigned long long v = __hip_atomic_load(pr + k, __ATOMIC_RELAXED, __HIP_MEMORY_SCOPE_AGENT);
      s += __uint_as_float((unsigned)v); q += __uint_as_float((unsigned)(v >> 32));
    }
    s += __shfl_xor(s, 16); s += __shfl_xor(s, 32);
    q += __shfl_xor(q, 16); q += __shfl_xor(q, 32);
    const float mean = s * (1.0f / 1024.0f);
    const float var = fmaxf(q * (1.0f / 1024.0f) - mean * mean, 0.f);
    const float rstd = rsqrtf(var + EPS);
#pragma unroll
    for (int ni = 0; ni < 4; ++ni) {
      acc[ni][mi][0] = (acc[ni][mi][0] - mean) * rstd * gam[ni].x + bet[ni].x; acc[ni][mi][1] = (acc[ni][mi][1] - mean) * rstd * gam[ni].y + bet[ni].y;
      acc[ni][mi][2] = (acc[ni][mi][2] - mean) * rstd * gam[ni].z + bet[ni].z; acc[ni][mi][3] = (acc[ni][mi][3] - mean) * rstd * gam[ni].w + bet[ni].w;
    }
  }
  if (EPI == EPI_OUT0) {
    stage_f32_T(acc, stg, (float*)(p.ws + OFF_X1) + (size_t)rbase * 1024 + cb, 1024, lane);
    const float* m1 = mod + (3 + mv) * 3072 + cb + f0;
#pragma unroll
    for (int ni = 0; ni < 4; ++ni) {
      const float4 sh = *(const float4*)(m1 + ni * 16), sc = *(const float4*)(m1 + 1024 + ni * 16);
#pragma unroll
      for (int mi = 0; mi < 4; ++mi) {
        acc[ni][mi][0] = acc[ni][mi][0] * (1.f + sc.x) + sh.x; acc[ni][mi][1] = acc[ni][mi][1] * (1.f + sc.y) + sh.y;
        acc[ni][mi][2] = acc[ni][mi][2] * (1.f + sc.z) + sh.z; acc[ni][mi][3] = acc[ni][mi][3] * (1.f + sc.w) + sh.w;
      }
    }
    stage_bf16_T(acc, stg, (u16*)(p.ws + OFF_H) + (size_t)rbase * 1024 + cb, 1024, lane, 1.0f);
  } else {
    stage_f32_T(acc, stg, p.out + (size_t)rbase * 1024 + cb, 1024, lane);
  }
}

DI void glds16_asm(const void* gsrc, unsigned lds_dst) {
  unsigned keep;
  asm volatile("s_mov_b32 %0, m0\n\ts_mov_b32 m0, %2\n\ts_nop 0\n\tglobal_load_lds_dwordx4 %1, off\n\ts_mov_b32 m0, %0"
               : "=&s"(keep) : "v"(gsrc), "s"(lds_dst) : "memory");
}
template <int LAYER>
DI void attn_issue(unsigned st, const u16* Kg0, const u16* Kg1, const u16* Vg, int vs, int key0, int tid) {
  const unsigned wb = __builtin_amdgcn_readfirstlane(st + (unsigned)(tid >> 6) * 1024u);
  if (LAYER == 0) {
#pragma unroll
    for (int i = 0; i < 2; ++i) {
      const int id = tid + 256 * i, row = id >> 3, c = (id & 7) ^ ((row >> 1) & 7);
      glds16_asm(Kg0 + (size_t)(key0 + row) * 64 + c * 8, wb + i * 4096);
    }
#pragma unroll
    for (int i = 0; i < 2; ++i) {
      const int id = tid + 256 * i, row = id >> 3, c = (id & 7) ^ ((row >> 1) & 7);
      glds16_asm(Vg + (size_t)row * vs + key0 + c * 8, wb + 8192 + i * 4096);
    }
  } else {
    {
      const int id = tid, row = id >> 3, c = (id & 7) ^ ((row >> 1) & 7);
      glds16_asm(Kg0 + (size_t)(key0 + row) * 64 + c * 8, wb);
      glds16_asm(Kg1 + (size_t)(key0 + row) * 64 + c * 8, wb + 4096);
    }
#pragma unroll
    for (int i = 0; i < 2; ++i) {
      const int id = tid + 256 * i, row = id >> 2, c = (id & 3) ^ ((row >> 2) & 3);
      glds16_asm(Vg + (size_t)(key0 >> 5) * 4096 + row * 32 + c * 8, wb + 8192 + i * 4096);
    }
  }
}

template <int LAYER>
DI void flash_lds(const u16* Qp, unsigned char* ring, const u16* Kg0, const u16* Kg1, const u16* Vg, int vs, int kmap,
                  int tb1, int te1, int tb2, int te2, bool use_mask, int qpos0, float m_init, float l_init,
                  f32x16 (&O)[LAYER ? 4 : 2], float& l_out) {
  constexpr int DV = LAYER ? 128 : 64;
  constexpr int NSUB = LAYER ? 1 : 2;
  constexpr int KS = 32 * NSUB;
  const int tid = threadIdx.x, lane = tid & 63, r = lane & 31, h = lane >> 5;
  bf16x8 qf[4];
#pragma unroll
  for (int ks = 0; ks < 4; ++ks) qf[ks] = *(const bf16x8*)(Qp + (size_t)r * 1024 + ks * 16 + 8 * h);
#pragma unroll
  for (int d = 0; d < DV / 32; ++d)
#pragma unroll
    for (int i = 0; i < 16; ++i) O[d][i] = 0.f;
  float m = m_init;
  const f32x16 zero16 = {0.f, 0.f, 0.f, 0.f, 0.f, 0.f, 0.f, 0.f, 0.f, 0.f, 0.f, 0.f, 0.f, 0.f, 0.f, 0.f};
  f32x16 L = zero16;
  L[0] = l_init;
  const short one_bf = (r == 0 || r == 4) ? (short)0x3F80 : (short)0;
  const bf16x8 onesf = {one_bf, one_bf, one_bf, one_bf, one_bf, one_bf, one_bf, one_bf};
  const int pr = (r & 0x13) | ((r & 4) << 1) | ((r & 8) >> 1);
  const int n1 = te1 - tb1, ntot = n1 + (te2 - tb2);
  const int koff = (LAYER ? kmap * 4096 : 0) + pr * 128;
  const int ksw = (pr >> 1) & 7;
  const int voff = 8192 + (LAYER ? r * 64 : r * 128);
  const int vsw = LAYER ? ((r >> 2) & 3) : ((r >> 1) & 7);
  asm volatile("" : "+v"(qf[0]), "+v"(qf[1]), "+v"(qf[2]), "+v"(qf[3]));
  asm volatile("s_waitcnt vmcnt(0)" ::: "memory");
#define TKEY(it_) (((it_) < n1 ? tb1 + (it_) : tb2 + ((it_) - n1)) * KS)
  const unsigned ring_lds = (unsigned)(size_t)ring;
  attn_issue<LAYER>(ring_lds, Kg0, Kg1, Vg, vs, TKEY(0), tid);
  if (ntot > 1) attn_issue<LAYER>(ring_lds + 16384, Kg0, Kg1, Vg, vs, TKEY(1), tid);
  if (ntot > 2) attn_issue<LAYER>(ring_lds + 32768, Kg0, Kg1, Vg, vs, TKEY(2), tid);
#define QK_STAGE(ST_, SV_)                                                                                            \
  _Pragma("unroll") for (int u = 0; u < NSUB; ++u) {                                                                  \
    bf16x8 kf[4];                                                                                                     \
    _Pragma("unroll") for (int ks = 0; ks < 4; ++ks)                                                                  \
      kf[ks] = *(const bf16x8*)((ST_) + koff + u * 4096 + (((ks * 2 + h) ^ ksw) * 16));                               \
    SV_[u] = MFMA32(kf[0], qf[0], zero16);                                                                            \
    _Pragma("unroll") for (int ks = 1; ks < 4; ++ks) SV_[u] = MFMA32(kf[ks], qf[ks], SV_[u]);                         \
  }
  f32x16 S[NSUB], Sn[NSUB];
  {
    const int later = (ntot > 2 ? 2 : ntot - 1) * 4 + 2;
    if (later >= 10) asm volatile("s_waitcnt vmcnt(10)" ::: "memory");
    else if (later >= 6) asm volatile("s_waitcnt vmcnt(6)" ::: "memory");
    else asm volatile("s_waitcnt vmcnt(2)" ::: "memory");
    __builtin_amdgcn_s_barrier();
    QK_STAGE(ring, S)
  }
  for (int it = 0; it < ntot; ++it) {
    const int rem = ntot - 1 - it;
    if (rem >= 2) asm volatile("s_waitcnt vmcnt(6)" ::: "memory");
    else if (rem == 1) asm volatile("s_waitcnt vmcnt(2)" ::: "memory");
    else asm volatile("s_waitcnt vmcnt(0)" ::: "memory");
    __builtin_amdgcn_s_barrier();
    if (it + 3 < ntot) attn_issue<LAYER>(ring_lds + ((it + 3) & 3) * 16384, Kg0, Kg1, Vg, vs, TKEY(it + 3), tid);
    const unsigned char* st = ring + (it & 3) * 16384;
    const int key0 = TKEY(it);
    if (rem >= 1) {
      const unsigned char* stn = ring + ((it + 1) & 3) * 16384;
      QK_STAGE(stn, Sn)
    }
    if (use_mask && it < n1 && !(key0 >= qpos0 + 31 - 128 && key0 + KS - 1 <= qpos0 + 128)) {
      const int q = qpos0 + r;
#pragma unroll
      for (int u = 0; u < NSUB; ++u)
#pragma unroll
        for (int i = 0; i < 16; ++i) {
          const int key = key0 + 32 * u + (i & 3) + 4 * ((i >> 2) & 1) + 8 * h + 16 * (i >> 3);
          const int dlt = key - q;
          S[u][i] = (dlt <= 128 && dlt >= -128) ? S[u][i] : -1e30f;
        }
    }
    float mx = S[0][0];
#pragma unroll
    for (int u = 0; u < NSUB; ++u)
#pragma unroll
      for (int i = 0; i < 16; ++i) mx = fmaxf(mx, S[u][i]);
    {
      const unsigned mu = __float_as_uint(mx);
      const auto sw = __builtin_amdgcn_permlane32_swap(mu, mu, false, false);
      mx = fmaxf(__uint_as_float(sw[0]), __uint_as_float(sw[1]));
    }
    const float mn = fmaxf(m, mx);
    if (__builtin_amdgcn_ballot_w64(mn != m) != 0) {
      const float alpha = exp2f_fast(m - mn);
#pragma unroll
      for (int d = 0; d < DV / 32; ++d)
#pragma unroll
        for (int i = 0; i < 16; ++i) O[d][i] *= alpha;
      L[0] *= alpha;
    }
    m = mn;
    const float nm = -mn;
#pragma unroll
    for (int u = 0; u < NSUB; ++u) {
      S[u] = S[u] + nm;
#pragma unroll
      for (int i = 0; i < 16; ++i) S[u][i] = exp2f_fast(S[u][i]);
    }
#pragma unroll
    for (int u = 0; u < NSUB; ++u) {
      bf16x8 pf[2];
#pragma unroll
      for (int s = 0; s < 2; ++s) {
        uint4 w;
        w.x = pack2(S[u][8 * s + 0], S[u][8 * s + 1]); w.y = pack2(S[u][8 * s + 2], S[u][8 * s + 3]);
        w.z = pack2(S[u][8 * s + 4], S[u][8 * s + 5]); w.w = pack2(S[u][8 * s + 6], S[u][8 * s + 7]);
        pf[s] = __builtin_bit_cast(bf16x8, w);
      }
#pragma unroll
      for (int s = 0; s < 2; ++s) L = MFMA32(onesf, pf[s], L);
#pragma unroll
      for (int d = 0; d < DV / 32; ++d)
#pragma unroll
        for (int s = 0; s < 2; ++s) {
          const bf16x8 vf = *(const bf16x8*)(st + voff + d * 32 * (LAYER ? 64 : 128) + (((4 * u + 2 * s + h) ^ vsw) * 16));
          O[d] = MFMA32(vf, pf[s], O[d]);
        }
    }
    if (rem >= 1) {
#pragma unroll
      for (int u = 0; u < NSUB; ++u) S[u] = Sn[u];
    }
  }
#undef QK_STAGE
#undef TKEY
  l_out = L[0];
}

DI void attn0_phase(const Params& p, unsigned char* smem, int cidx) {
  const int tid = threadIdx.x, lane = tid & 63, wave = tid >> 6;
  int* cnt = (int*)(p.ws + OFF_CNT) + cidx;
  int* s_item = (int*)(smem + 65536);
  const u16* Q = (const u16*)(p.ws + OFF_Q);
  const u16* G = (const u16*)(p.ws + OFF_G);
  u16* AO = (u16*)(p.ws + OFF_AO);
  for (int round = 0;; ++round) {
    if (tid == 0) *s_item = round == 0 ? (int)blockIdx.x : (int)gridDim.x + atomicAdd(cnt, 1);
    __syncthreads();
    const int item = *s_item;
    __syncthreads();
    if (item >= 768) break;
    int br, row0, head, vs, tb1, te1, tb2 = 0, te2 = 0, qpos0 = 0;
    bool use_mask = false;
    const u16 *Kp, *Vp;
    if (item < 256) {
      br = item >> 7;
      const int r = item & 127, b = r >> 6, kvh = (r >> 5) & 1, qb = r & 31;
      head = kvh * 4 + wave;
      row0 = M_CTX + b * 1024 + qb * 32;
      Kp = (const u16*)(p.ws + (br ? OFF_KSB : OFF_KSA)) + (size_t)(b * 2 + kvh) * 1280 * 64;
      Vp = (const u16*)(p.ws + (br ? OFF_VSB : OFF_VSA)) + (size_t)(b * 2 + kvh) * 64 * 1280;
      vs = 1280;
      if (br == 0) { tb1 = 0; te1 = 20; }
      else {
        const int q0 = qb * 32;
        tb1 = q0 >= 128 ? (q0 - 128) >> 6 : 0;
        te1 = ((q0 + 159) >> 6) + 1; if (te1 > 16) te1 = 16;
        tb2 = 16; te2 = 20; use_mask = true; qpos0 = q0;
      }
    } else {
      int r = item - 256;
      br = r >> 8; r &= 255;
      const int b = r >> 4, kvh = (r >> 3) & 1, qb = r & 7;
      head = kvh * 4 + wave;
      row0 = b * 256 + qb * 32;
      Kp = (const u16*)(p.ws + (br ? OFF_KCB : OFF_KCA)) + (size_t)(b * 2 + kvh) * 256 * 64;
      Vp = (const u16*)(p.ws + (br ? OFF_VCB : OFF_VCA)) + (size_t)(b * 2 + kvh) * 64 * 256;
      vs = 256; tb1 = 0; te1 = 4;
    }
    const float m_init = br ? p.in[I_SINK][head] * LOG2E : -1e30f;
    const float l_init = br ? 1.0f : 0.0f;
    const int col0 = br * 512 + head * 64;
    f32x16 O[2];
    float l;
    flash_lds<0>(Q + (size_t)row0 * 1024 + col0, smem, Kp, Kp, Vp, vs, 0, tb1, te1, tb2, te2, use_mask, qpos0, m_init, l_init, O, l);
    const float inv = 1.0f / l;
    const int row = row0 + (lane & 31), h = lane >> 5;
#pragma unroll
    for (int d = 0; d < 2; ++d)
#pragma unroll
      for (int g = 0; g < 4; ++g) {
        const size_t o = (size_t)row * 1024 + col0 + d * 32 + 8 * g + 4 * h;
        const uint2 gv = *(const uint2*)(G + o);
        uint2 ov;
        ov.x = pack2(O[d][4 * g + 0] * inv * bflo(gv.x), O[d][4 * g + 1] * inv * bfhi(gv.x));
        ov.y = pack2(O[d][4 * g + 2] * inv * bflo(gv.y), O[d][4 * g + 3] * inv * bfhi(gv.y));
        st8_wt(AO + o, ov);
      }
  }
}

DI void attn1_phase(const Params& p, unsigned char* smem, int cidx) {
  const int tid = threadIdx.x, lane = tid & 63, wave = tid >> 6;
  int* cnt = (int*)(p.ws + OFF_CNT) + cidx;
  int* s_item = (int*)(smem + 65536);
  const u16* Q = (const u16*)(p.ws + OFF_Q);
  const u16* G = (const u16*)(p.ws + OFF_G);
  u16* AO = (u16*)(p.ws + OFF_AO);
  float* xch = (float*)smem;
  float lam;
  {
    const float a = p.in[I_LQ1][lane] * p.in[I_LK1][lane];
    const float b = p.in[I_LQ2][lane] * p.in[I_LK2][lane];
    lam = __expf(wave_sum(a)) - __expf(wave_sum(b)) + LAM_INIT;
  }
  const int map = wave & 1, qsub = wave >> 1;
  for (int round = 0;; ++round) {
    if (tid == 0) *s_item = round == 0 ? (int)blockIdx.x : (int)gridDim.x + atomicAdd(cnt, 1);
    __syncthreads();
    const int item = *s_item;
    __syncthreads();
    if (item >= 768) break;
    int row0, head, vs, te1;
    const u16 *Kp, *Vp;
    if (item < 256) {
      const int b = item >> 7, hd = (item >> 4) & 7, qb = item & 15;
      head = hd;
      row0 = M_CTX + b * 1024 + qb * 64 + qsub * 32;
      Kp = (const u16*)(p.ws + OFF_KSC) + (size_t)(b * 16 + hd * 2) * 1280 * 64;
      Vp = (const u16*)(p.ws + OFF_VSC) + (size_t)(b * 8 + hd) * 128 * 1280;
      vs = 1280; te1 = 40;
    } else {
      const int r = item - 256, b = r >> 5, hd = (r >> 2) & 7, qb = r & 3;
      head = hd;
      row0 = b * 256 + qb * 64 + qsub * 32;
      Kp = (const u16*)(p.ws + OFF_KCC) + (size_t)(b * 16 + hd * 2) * 256 * 64;
      Vp = (const u16*)(p.ws + OFF_VCC) + (size_t)(b * 8 + hd) * 128 * 256;
      vs = 256; te1 = 8;
    }
    f32x16 O[4];
    float l;
    flash_lds<1>(Q + (size_t)row0 * 1024 + (head * 2 + map) * 64, smem, Kp, Kp + (size_t)vs * 64, Vp, vs, map,
                 0, te1, 0, 0, false, 0, -1e30f, 0.0f, O, l);
    const float inv = 1.0f / l;
    __syncthreads();
    if (map == 1) {
#pragma unroll
      for (int d = 0; d < 4; ++d)
#pragma unroll
        for (int i = 0; i < 16; ++i) xch[(qsub * 64 + d * 16 + i) * 64 + lane] = O[d][i] * inv;
    }
    __syncthreads();
    if (map == 0) {
      float ss = 0.f;
#pragma unroll
      for (int d = 0; d < 4; ++d)
#pragma unroll
        for (int i = 0; i < 16; ++i) {
          const float o = O[d][i] * inv - lam * xch[(qsub * 64 + d * 16 + i) * 64 + lane];
          O[d][i] = o;
          ss += o * o;
        }
      ss += __shfl_xor(ss, 32);
      const float rr = rsqrtf(ss * (1.0f / 128.0f) + EPS) * (1.0f - LAM_INIT);
      const int row = row0 + (lane & 31), h = lane >> 5;
      const float* sw = p.in[I_SUBLN];
#pragma unroll
      for (int d = 0; d < 4; ++d)
#pragma unroll
        for (int g = 0; g < 4; ++g) {
          const int dv = d * 32 + 8 * g + 4 * h;
          const size_t o = (size_t)row * 1024 + head * 128 + dv;
          const uint2 gv = *(const uint2*)(G + o);
          const float4 w4 = *(const float4*)(sw + dv);
          uint2 ov;
          ov.x = pack2(O[d][4 * g + 0] * rr * w4.x * bflo(gv.x), O[d][4 * g + 1] * rr * w4.y * bfhi(gv.x));
          ov.y = pack2(O[d][4 * g + 2] * rr * w4.z * bflo(gv.y), O[d][4 * g + 3] * rr * w4.w * bfhi(gv.y));
          st8_wt(AO + o, ov);
        }
    }
  }
}

DI unsigned bar_ld(unsigned* p) { return __hip_atomic_load(p, __ATOMIC_RELAXED, __HIP_MEMORY_SCOPE_AGENT); }
DI unsigned bar_add(unsigned* p, unsigned v) { return __hip_atomic_fetch_add(p, v, __ATOMIC_RELAXED, __HIP_MEMORY_SCOPE_AGENT); }
DI void grid_bar(unsigned* bar, unsigned& epoch) {
  asm volatile("s_waitcnt vmcnt(0)" ::: "memory");
  __syncthreads();
  if (threadIdx.x == 0) {
    epoch += 1;
    __builtin_amdgcn_fence(__ATOMIC_RELEASE, "agent");
    asm volatile("s_waitcnt vmcnt(0)" ::: "memory");
    const unsigned ng = gridDim.x < 8 ? gridDim.x : 8;
    const unsigned grp = blockIdx.x % ng;
    const unsigned nloc = (gridDim.x - grp + ng - 1) / ng;
    const unsigned old = bar_add(&bar[64 * (1 + grp)], 1u);
    if (old + 1u == epoch * nloc) {
      const unsigned o2 = bar_add(&bar[0], 1u);
      if (o2 + 1u == epoch * ng) __hip_atomic_store(&bar[64 * 9], epoch, __ATOMIC_RELAXED, __HIP_MEMORY_SCOPE_AGENT);
    }
    while (bar_ld(&bar[64 * 9]) < epoch) __builtin_amdgcn_s_sleep(1);
    __builtin_amdgcn_fence(__ATOMIC_ACQUIRE, "agent");
    asm volatile("s_waitcnt vmcnt(0)" ::: "memory");
  }
  __syncthreads();
}

#define XB_TMO      128
#define XB_XCNT(j)  (256  + 64 * (j))
#define XB_XSUB(j)  (1280 + 64 * (j))
#define XB_XGEN(j)  (2304 + 64 * (j))
#define XB_TOP      3328
#define XB_TOPGEN   3392
#define XCD_BAR_WORDS 3456
#define XB_SPIN_CAP (1u << 18)
#define LAS __attribute__((address_space(3)))

__device__ __forceinline__ unsigned xb_ld(unsigned* p)              { return __hip_atomic_load(p, __ATOMIC_RELAXED, __HIP_MEMORY_SCOPE_AGENT); }
__device__ __forceinline__ unsigned xb_add(unsigned* p, unsigned v) { return __hip_atomic_fetch_add(p, v, __ATOMIC_RELAXED, __HIP_MEMORY_SCOPE_AGENT); }
__device__ __forceinline__ unsigned xb_xcc_id() { return (unsigned)__builtin_amdgcn_s_getreg((3 << 11) | 20) & 0xFu; }
#define XB_SPIN(cond, bar) do { unsigned _sp = 0; while (cond) { __builtin_amdgcn_s_sleep(1); \
    if ((++_sp & 255u) == 0u) { if (xb_ld(&(bar)[XB_TMO])) break; if (_sp > XB_SPIN_CAP) { atomicAdd(&(bar)[XB_TMO], 1u); break; } } } } while (0)

struct XcdBarrier {
    unsigned* bar; unsigned x;
    volatile LAS unsigned* st;
};

__device__ __forceinline__ XcdBarrier xcd_barrier_post(unsigned* bar, volatile LAS unsigned* st) {
    XcdBarrier b; b.bar = bar; b.x = xb_xcc_id(); b.st = st;
    if (threadIdx.x == 0) (void)xb_add(&bar[XB_XCNT(b.x)], 1u);
    return b;
}
__device__ __forceinline__ void xcd_barrier_complete(unsigned* bar, unsigned x, unsigned& nloc, unsigned& nx) {
    const unsigned G = gridDim.x * gridDim.y * gridDim.z;
    unsigned sum, cnt, mine, sp = 0u;
    for (;;) {
        sum = 0u; cnt = 0u; mine = 0u;
#pragma unroll
        for (unsigned j = 0; j < 16; ++j) { const unsigned c = xb_ld(&bar[XB_XCNT(j)]); sum += c; cnt += (c > 0u) ? 1u : 0u; mine = (j == x) ? c : mine; }
        if (sum == G) break;
        __builtin_amdgcn_s_sleep(1);
        if ((++sp & 255u) == 0u) { if (xb_ld(&bar[XB_TMO])) break; if (sp > XB_SPIN_CAP) { atomicAdd(&bar[XB_TMO], 1u); break; } }
    }
    nloc = mine > 0u ? mine : 1u; nx = cnt > 0u ? cnt : 1u;
}

__device__ __forceinline__ void xcd_barrier(const XcdBarrier& b) {
    asm volatile("s_waitcnt vmcnt(0)" ::: "memory");
    __syncthreads();
    if (threadIdx.x == 0) {
        unsigned* bar = b.bar;
        __builtin_amdgcn_s_waitcnt(0);
        unsigned nloc = b.st[0], nx = b.st[1];
        if (nloc == 0u) { xcd_barrier_complete(bar, b.x, nloc, nx); b.st[0] = nloc; b.st[1] = nx; }
        const unsigned old = xb_add(&bar[XB_XSUB(b.x)], 1u);
        const unsigned gen = old / nloc;
        if (old + 1u == (gen + 1u) * nloc) {
            __builtin_amdgcn_fence(__ATOMIC_RELEASE, "agent");
            asm volatile("s_waitcnt vmcnt(0)" ::: "memory");
            const unsigned og = xb_add(&bar[XB_TOP], 1u);
            const unsigned tg = og / nx;
            if (og + 1u == (tg + 1u) * nx) xb_add(&bar[XB_TOPGEN], 1u);
            else XB_SPIN(xb_ld(&bar[XB_TOPGEN]) == tg, bar);
            __builtin_amdgcn_fence(__ATOMIC_ACQUIRE, "agent");
            xb_add(&bar[XB_XGEN(b.x)], 1u);
            asm volatile("s_waitcnt vmcnt(0)" ::: "memory");
        } else {
            XB_SPIN(xb_ld(&bar[XB_XGEN(b.x)]) == gen, bar);
            __builtin_amdgcn_fence(__ATOMIC_ACQUIRE, "agent");
            asm volatile("s_waitcnt vmcnt(0)" ::: "memory");
        }
    }
    __syncthreads();
}

__global__ void __launch_bounds__(256, 2) mega(Params p) {
  extern __shared__ __attribute__((aligned(16))) unsigned char smem[];
  cg::grid_group grid = cg::this_grid();
  unsigned* bar = (unsigned*)(p.ws + OFF_BAR);
  unsigned epoch = 0; (void)epoch;
  volatile LAS unsigned* xb_st = (volatile LAS unsigned*)(smem + 65536 + 16);
  if (threadIdx.x == 0) { xb_st[0] = 0u; xb_st[1] = 0u; }
  __syncthreads();
  XcdBarrier xb = xcd_barrier_post(bar, xb_st);
#define grid_bar(b_, e_) xcd_barrier(xb)
  if (p.ph_hi > 1000) grid.sync();
  int cidx = 0;
#define PHASE(k, call) if (p.ph_lo <= (k) && (k) < p.ph_hi) { { const bool EPI_ON = true; (void)EPI_ON; call; } if ((REP_MASK >> (k)) & 1) { const bool EPI_ON = (REP_EPI != 0); (void)EPI_ON; grid_bar(bar, epoch); call; } if ((k) + 1 < p.ph_hi) grid_bar(bar, epoch); }
  const bool fuse_ln = (p.ph_hi - p.ph_lo == 10) && (((gridDim.x & 7) == 0) ? ((gridDim.x >> 3) >= 48) : (gridDim.x >= 384));
  PHASE(0, phase0(p, smem))
  PHASE(1, phase_h0(p))
  PHASE(2, gemm_phase<EPI_IN0>(p, smem, (const u16*)(p.ws + OFF_H), (const u16*)(p.ws + OFF_WIN0), 2560, EPI_ON))
  PHASE(3, attn0_phase(p, smem, cidx++))
  PHASE(4, gemm_phase<EPI_OUT0>(p, smem, (const u16*)(p.ws + OFF_AO), (const u16*)(p.ws + OFF_WOUT0), 1024, EPI_ON, fuse_ln))
  if (!fuse_ln) { PHASE(5, phase_ln<false>(p)) }
  PHASE(6, gemm_phase<EPI_IN1>(p, smem, (const u16*)(p.ws + OFF_H), (const u16*)(p.ws + OFF_WIN1), 4096, EPI_ON))
  PHASE(7, attn1_phase(p, smem, cidx++))
  if (fuse_ln) {
    if (p.ph_lo <= 8 && 8 < p.ph_hi) gemm_phase<EPI_OUT1>(p, smem, (const u16*)(p.ws + OFF_AO), (const u16*)(p.ws + OFF_WOUT1), 1024, true, true);
  } else {
    PHASE(8, gemm_phase<EPI_OUT1>(p, smem, (const u16*)(p.ws + OFF_AO), (const u16*)(p.ws + OFF_WOUT1), 1024, EPI_ON, false))
    PHASE(9, phase_ln<true>(p))
  }
}

extern "C" void kernel_launch(void* const* d_in, const int* in_sizes, int n_in, void* d_out, int out_size, void* d_ws,
                              size_t ws_size, hipStream_t stream) {
  static int grid_blocks = 0;
  if (!grid_blocks) {
    int dev = 0, cus = 0, per_cu = 0;
    (void)hipGetDevice(&dev);
    (void)hipDeviceGetAttribute(&cus, hipDeviceAttributeMultiprocessorCount, dev);
    if (hipFuncSetAttribute((const void*)mega, hipFuncAttributeMaxDynamicSharedMemorySize, LDS_BYTES) != hipSuccess)
      fprintf(stderr, "kernel_launch: hipFuncSetAttribute failed\n");
    if (hipOccupancyMaxActiveBlocksPerMultiprocessor(&per_cu, (const void*)mega, 256, LDS_BYTES) != hipSuccess || per_cu < 1) {
      fprintf(stderr, "kernel_launch: occupancy query gave %d\n", per_cu);
      per_cu = 1;
    }
    (void)hipGetLastError();
    if (per_cu > 2) per_cu = 2;
    if (cus <= 0) cus = 256;
    grid_blocks = cus * per_cu;
    if (ws_size < WS_END) fprintf(stderr, "kernel_launch: workspace too small\n");
  }
  (void)hipMemsetAsync((unsigned char*)d_ws + OFF_BAR, 0, BAR_BYTES, stream);
  Params p{};
  for (int i = 0; i < 26; ++i) p.in[i] = (const float*)d_in[i];
  p.out = (float*)d_out;
  p.ws = (unsigned char*)d_ws;
#if N_LAUNCH_MULTI
  for (int ph = 0; ph < 10; ++ph) {
    p.ph_lo = ph; p.ph_hi = ph + 1;
    hipLaunchKernelGGL(mega, dim3(grid_blocks), dim3(256), LDS_BYTES, stream, p);
  }
#else
  p.ph_lo = 0; p.ph_hi = 10;
  void* args[] = {&p};
  hipError_t e = hipLaunchCooperativeKernel((void*)mega, dim3(grid_blocks), dim3(256), args, LDS_BYTES, stream);
  if (e != hipSuccess) fprintf(stderr, "cooperative launch failed: %s (grid %d)\n", hipGetErrorString(e), grid_blocks);
#endif
}
```
